# Optimizing an MI355X kernel written in HIP

```python
import math
import jax, jax.numpy as jnp
from jax import lax
import numpy as np

D_MODEL = 1024
BATCH = 4
SEQ = 4096
DEPTH = 4

N_MEM = 256
N_HEADS = 4
HEAD_DIM = 64
BRANCH_W = N_HEADS * HEAD_DIM
N_BRANCH = 5
ROPE_THETA = 500000.0
ROT_64 = 16
ROT_32 = 8
Q_BLOCK = 128
IDX_HEADS = 8
IDX_DIM = 32
TOPK_MAX = 256
MOBA_BLOCK = 256
MOBA_TOPK = 3
MOBA_Q_CHUNK = 64
DIFF_DIM = 32
Q_LORA = 256
KV_LORA = 128
MLA_NOPE = 64
MLA_ROPE = 32
MLA_V = 64
DN_ALPHA = (2 * DEPTH) ** 0.25
DN_BETA = (8 * DEPTH) ** -0.25
LN_EPS = 1e-5
RMS_EPS = 1e-6

IN_LAYOUT = (
    ("a_q", BRANCH_W), ("a_k", BRANCH_W), ("a_v", BRANCH_W),
    ("i_q", IDX_HEADS * IDX_DIM), ("i_k", IDX_DIM), ("i_w", IDX_HEADS),
    ("b_q", BRANCH_W), ("b_k", BRANCH_W), ("b_v", BRANCH_W),
    ("c_q", BRANCH_W), ("c_k", BRANCH_W), ("c_v", BRANCH_W),
    ("d_cq", Q_LORA), ("d_ckv", KV_LORA), ("d_kr", MLA_ROPE),
    ("e_q", BRANCH_W),
    ("z", N_BRANCH * BRANCH_W),
    ("g", N_BRANCH * D_MODEL),
)
IN_WIDTH = sum(s for _, s in IN_LAYOUT)

kernel_name = "hybrid_gated_dsa_moba_diff_mla_mem_deepnorm"


def split_projection(h):
    sizes = [s for _, s in IN_LAYOUT]
    offsets = [int(o) for o in np.cumsum(sizes)[:-1]]
    parts = jnp.split(h, offsets, axis=-1)
    return {name: p for (name, _), p in zip(IN_LAYOUT, parts)}


def layer_norm(x, g, b):
    xf = x.astype(jnp.float32)
    mu = jnp.mean(xf, -1, keepdims=True)
    var = jnp.mean(jnp.square(xf - mu), -1, keepdims=True)
    return ((xf - mu) * lax.rsqrt(var + LN_EPS) * g + b).astype(x.dtype)


def rms_norm(x, g):
    xf = x.astype(jnp.float32)
    return (xf * lax.rsqrt(jnp.mean(jnp.square(xf), -1, keepdims=True) + RMS_EPS) * g).astype(x.dtype)


def rope_tables(seq, rot_dim):
    pos = jnp.arange(seq, dtype=jnp.float32)
    inv = ROPE_THETA ** (-jnp.arange(0, rot_dim, 2, dtype=jnp.float32) / rot_dim)
    ang = pos[:, None] * inv[None, :]
    return jnp.cos(ang), jnp.sin(ang)


def apply_rope(x, cos, sin):
    half = x.shape[-1] // 2
    x1, x2 = x[..., :half], x[..., half:]
    c = cos[None, :, None, :].astype(x.dtype)
    s = sin[None, :, None, :].astype(x.dtype)
    return jnp.concatenate([x1 * c - x2 * s, x2 * c + x1 * s], -1)


def partial_rope(x, cos, sin):
    r = 2 * cos.shape[-1]
    return jnp.concatenate([apply_rope(x[..., :r], cos, sin), x[..., r:]], -1)


def to_blocks(x, blk):
    b, t = x.shape[:2]
    return jnp.moveaxis(x.reshape((b, t // blk, blk) + x.shape[2:]), 1, 0)


def from_blocks(y):
    y = jnp.moveaxis(y, 0, 1)
    return y.reshape((y.shape[0], -1) + y.shape[3:])


def sweep(fn, qs, blk):
    t = qs[0].shape[1]
    starts = jnp.arange(t // blk, dtype=jnp.int32) * blk
    out = lax.map(lambda a: fn(a[0], *a[1:]), (starts,) + tuple(to_blocks(q, blk) for q in qs))
    return from_blocks(out)


def dsa_attention(q, k, v, qi, ki, wi):
    b, t = q.shape[:2]
    topk = min(TOPK_MAX, t // 4)
    kpos = jnp.arange(t)
    bidx = jnp.arange(b)[:, None, None]
    scale = HEAD_DIM ** -0.5
    idx_scale = (IDX_HEADS * IDX_DIM) ** -0.5

    def block(start, qb, qib, wib):
        qpos = start + jnp.arange(Q_BLOCK)
        causal = kpos[None, :] <= qpos[:, None]
        logits = jnp.einsum('bqhd,bkd->bqhk', qib, ki)
        score = jnp.einsum('bqhk,bqh->bqk', jax.nn.relu(logits), wib).astype(jnp.float32) * idx_scale
        score = jnp.where(causal[None], score, -jnp.inf)
        _, sel = lax.top_k(score, topk)
        valid = sel <= qpos[None, :, None]
        kg = k[bidx, sel]
        vg = v[bidx, sel]
        s = jnp.einsum('bqhd,bqkhd->bqhk', qb, kg).astype(jnp.float32) * scale
        s = jnp.where(valid[:, :, None, :], s, -jnp.inf)
        p = jax.nn.softmax(s, axis=-1).astype(v.dtype)
        return jnp.einsum('bqhk,bqkhd->bqhd', p, vg)

    return sweep(block, (q, qi, wi), Q_BLOCK)


def moba_attention(q, k, v):
    b, t, h, dh = q.shape
    nb = -(-t // MOBA_BLOCK)
    n_sel = min(MOBA_TOPK, nb - 1)
    pad = nb * MOBA_BLOCK - t
    kp = jnp.pad(k, ((0, 0), (0, pad), (0, 0), (0, 0)))
    vp = jnp.pad(v, ((0, 0), (0, pad), (0, 0), (0, 0)))
    kb = kp.reshape(b, nb, MOBA_BLOCK, h, dh)
    vb = vp.reshape(b, nb, MOBA_BLOCK, h, dh)
    kbar = jnp.mean(kb, axis=2)
    kbh = jnp.moveaxis(kb, 3, 1)
    vbh = jnp.moveaxis(vb, 3, 1)
    bidx = jnp.arange(b)[:, None, None, None]
    hidx = jnp.arange(h)[None, None, :, None]
    blk_ids = jnp.arange(nb)
    own_off = jnp.arange(MOBA_BLOCK)
    scale = dh ** -0.5

    def block(start, qb):
        nq = qb.shape[1]
        qpos = start + jnp.arange(nq)
        own = start // MOBA_BLOCK
        k_own = lax.dynamic_slice_in_dim(kp, own * MOBA_BLOCK, MOBA_BLOCK, axis=1)
        v_own = lax.dynamic_slice_in_dim(vp, own * MOBA_BLOCK, MOBA_BLOCK, axis=1)
        own_pos = own * MOBA_BLOCK + own_off
        s_own = jnp.einsum('bqhd,bjhd->bqhj', qb, k_own).astype(jnp.float32) * scale
        s_own = jnp.where((own_pos[None, :] <= qpos[:, None])[None, :, None, :], s_own, -jnp.inf)
        if n_sel == 0:
            p = jax.nn.softmax(s_own, axis=-1).astype(v.dtype)
            return jnp.einsum('bqhj,bjhd->bqhd', p, v_own)
        gate = jnp.einsum('bqhd,bnhd->bqhn', qb, kbar).astype(jnp.float32)
        gate = jnp.where(blk_ids < own, gate, -jnp.inf)
        _, sel = lax.top_k(gate, n_sel)
        sel_valid = sel < own
        kg = kbh[bidx, hidx, sel]
        vg = vbh[bidx, hidx, sel]
        s_sel = jnp.einsum('bqhd,bqhsjd->bqhsj', qb, kg).astype(jnp.float32) * scale
        s_sel = jnp.where(sel_valid[..., None], s_sel, -jnp.inf).reshape(b, nq, h, n_sel * MOBA_BLOCK)
        p = jax.nn.softmax(jnp.concatenate([s_sel, s_own], -1), axis=-1).astype(v.dtype)
        p_sel = p[..., :n_sel * MOBA_BLOCK].reshape(b, nq, h, n_sel, MOBA_BLOCK)
        p_own = p[..., n_sel * MOBA_BLOCK:]
        return (jnp.einsum('bqhsj,bqhsjd->bqhd', p_sel, vg)
                + jnp.einsum('bqhj,bjhd->bqhd', p_own, v_own))

    return sweep(block, (q,), MOBA_Q_CHUNK)


def diff_attention(q, k, v, lam):
    t = q.shape[1]
    kpos = jnp.arange(t)
    scale = DIFF_DIM ** -0.5

    def block(start, qb):
        qpos = start + jnp.arange(Q_BLOCK)
        causal = kpos[None, :] <= qpos[:, None]
        s = jnp.einsum('bqhcd,bkhcd->bhcqk', qb, k).astype(jnp.float32) * scale
        p = jax.nn.softmax(jnp.where(causal, s, -jnp.inf), axis=-1)
        pd = (p[:, :, 0] - lam * p[:, :, 1]).astype(v.dtype)
        return jnp.einsum('bhqk,bkhd->bqhd', pd, v)

    return sweep(block, (q,), Q_BLOCK)


def mla_attention(qn, qr, kn, kr, v):
    t = qn.shape[1]
    kpos = jnp.arange(t)
    scale = (MLA_NOPE + MLA_ROPE) ** -0.5

    def block(start, qnb, qrb):
        qpos = start + jnp.arange(Q_BLOCK)
        causal = kpos[None, :] <= qpos[:, None]
        s = (jnp.einsum('bqhd,bkhd->bhqk', qnb, kn)
             + jnp.einsum('bqhr,bkr->bhqk', qrb, kr)).astype(jnp.float32) * scale
        p = jax.nn.softmax(jnp.where(causal, s, -jnp.inf), axis=-1).astype(v.dtype)
        return jnp.einsum('bhqk,bkhd->bqhd', p, v)

    return sweep(block, (qn, qr), Q_BLOCK)


def memory_attention(q, mk, mv):
    s = jnp.einsum('bthd,bmhd->bhtm', q, mk).astype(jnp.float32) * HEAD_DIM ** -0.5
    p = jax.nn.softmax(s, axis=-1).astype(mv.dtype)
    return jnp.einsum('bhtm,bmhd->bthd', p, mv)


def hybrid_layer(x, mem, rot64, rot32, rot_mla, layer_idx, w_in, mla_q_norm, w_uq, mla_kv_norm,
                 w_ukv, diff_lam, diff_norm, w_mem_kv, w_branch, w_out, ln_g, ln_b):
    b, t, d = x.shape
    pr = split_projection(x @ w_in)

    def heads(a, n, dd):
        return a.reshape(b, t, n, dd)

    aq = partial_rope(heads(pr['a_q'], N_HEADS, HEAD_DIM), *rot64)
    ak = partial_rope(heads(pr['a_k'], N_HEADS, HEAD_DIM), *rot64)
    av = heads(pr['a_v'], N_HEADS, HEAD_DIM)
    iq = partial_rope(heads(pr['i_q'], IDX_HEADS, IDX_DIM), *rot32)
    ik = partial_rope(pr['i_k'][:, :, None, :], *rot32)[:, :, 0]
    o_a = dsa_attention(aq, ak, av, iq, ik, pr['i_w'])

    bq = partial_rope(heads(pr['b_q'], N_HEADS, HEAD_DIM), *rot64)
    bk = partial_rope(heads(pr['b_k'], N_HEADS, HEAD_DIM), *rot64)
    o_b = moba_attention(bq, bk, heads(pr['b_v'], N_HEADS, HEAD_DIM))

    cq = partial_rope(heads(pr['c_q'], 2 * N_HEADS, DIFF_DIM), *rot32).reshape(b, t, N_HEADS, 2, DIFF_DIM)
    ck = partial_rope(heads(pr['c_k'], 2 * N_HEADS, DIFF_DIM), *rot32).reshape(b, t, N_HEADS, 2, DIFF_DIM)
    cv = heads(pr['c_v'], N_HEADS, 2 * DIFF_DIM)
    lam_init = 0.8 - 0.6 * math.exp(-0.3 * layer_idx)
    dl = diff_lam.astype(jnp.float32)
    lam = jnp.exp(jnp.sum(dl[0] * dl[1])) - jnp.exp(jnp.sum(dl[2] * dl[3])) + lam_init
    o_c = rms_norm(diff_attention(cq, ck, cv, lam), diff_norm) * (1.0 - lam_init)

    q_full = (rms_norm(pr['d_cq'], mla_q_norm) @ w_uq).reshape(b, t, N_HEADS, MLA_NOPE + MLA_ROPE)
    qn, qr = q_full[..., :MLA_NOPE], apply_rope(q_full[..., MLA_NOPE:], *rot_mla)
    kv = (rms_norm(pr['d_ckv'], mla_kv_norm) @ w_ukv).reshape(b, t, N_HEADS, MLA_NOPE + MLA_V)
    kn, dv = kv[..., :MLA_NOPE], kv[..., MLA_NOPE:]
    kr = apply_rope(pr['d_kr'][:, :, None, :], *rot_mla)[:, :, 0]
    o_d = mla_attention(qn, qr, kn, kr, dv)

    mkv = (mem @ w_mem_kv).reshape(b, mem.shape[1], 2, N_HEADS, HEAD_DIM)
    o_e = memory_attention(heads(pr['e_q'], N_HEADS, HEAD_DIM), mkv[:, :, 0], mkv[:, :, 1])

    o = jnp.stack([o_a, o_b, o_c, o_d, o_e], axis=2).reshape(b, t, N_BRANCH, BRANCH_W)
    y = o * jax.nn.silu(pr['z'].reshape(b, t, N_BRANCH, BRANCH_W))
    u = jnp.einsum('btnc,ncd->btnd', y, w_branch)
    g = jax.nn.sigmoid(pr['g'].reshape(b, t, N_BRANCH, d))
    out = jnp.sum(g * u, axis=2) @ w_out
    return layer_norm(DN_ALPHA * x + out, ln_g, ln_b)


def setup_inputs(seed: int = 0) -> dict:
    key = jax.random.key(seed)
    ks = jax.random.split(key, 16)
    f32 = jnp.float32

    def nrm(k, shape, scale):
        return jax.random.normal(k, shape, f32) * scale

    return {
        "x": nrm(ks[0], (BATCH, SEQ, D_MODEL), 1.0),
        "mem": nrm(ks[1], (BATCH, N_MEM, D_MODEL), 1.0),
        "ln0_g": 1.0 + nrm(ks[2], (D_MODEL,), 0.02),
        "ln0_b": nrm(ks[3], (D_MODEL,), 0.02),
        "w_in": nrm(ks[4], (DEPTH, D_MODEL, IN_WIDTH), D_MODEL ** -0.5),
        "mla_q_norm": 1.0 + nrm(ks[5], (DEPTH, Q_LORA), 0.02),
        "w_uq": nrm(ks[6], (DEPTH, Q_LORA, N_HEADS * (MLA_NOPE + MLA_ROPE)), Q_LORA ** -0.5),
        "mla_kv_norm": 1.0 + nrm(ks[7], (DEPTH, KV_LORA), 0.02),
        "w_ukv": nrm(ks[8], (DEPTH, KV_LORA, N_HEADS * (MLA_NOPE + MLA_V)), KV_LORA ** -0.5),
        "diff_lam": nrm(ks[9], (DEPTH, 4, DIFF_DIM), 0.1),
        "diff_norm": 1.0 + nrm(ks[10], (DEPTH, 2 * DIFF_DIM), 0.02),
        "w_mem_kv": nrm(ks[11], (DEPTH, D_MODEL, 2 * BRANCH_W), D_MODEL ** -0.5),
        "w_branch": nrm(ks[12], (DEPTH, N_BRANCH, BRANCH_W, D_MODEL), BRANCH_W ** -0.5 * DN_BETA),
        "w_out": nrm(ks[13], (DEPTH, D_MODEL, D_MODEL), D_MODEL ** -0.5 * DN_BETA),
        "ln_g": 1.0 + nrm(ks[14], (DEPTH, D_MODEL), 0.02),
        "ln_b": nrm(ks[15], (DEPTH, D_MODEL), 0.02),
    }


def reference(x, mem, ln0_g, ln0_b, w_in, mla_q_norm, w_uq, mla_kv_norm, w_ukv, diff_lam,
              diff_norm, w_mem_kv, w_branch, w_out, ln_g, ln_b):
    t = x.shape[1]
    rot64 = rope_tables(t, ROT_64)
    rot32 = rope_tables(t, ROT_32)
    rot_mla = rope_tables(t, MLA_ROPE)
    h = layer_norm(x, ln0_g, ln0_b)
    for l in range(DEPTH):
        h = hybrid_layer(h, mem, rot64, rot32, rot_mla, l, w_in[l], mla_q_norm[l], w_uq[l],
                         mla_kv_norm[l], w_ukv[l], diff_lam[l], diff_norm[l], w_mem_kv[l],
                         w_branch[l], w_out[l], ln_g[l], ln_b[l])
    return h
```

```cpp
#include <hip/hip_runtime.h>
#include <hip/hip_cooperative_groups.h>
#include <stdint.h>
#include <cstdio>
namespace cg = cooperative_groups;

typedef uint16_t bf16;
typedef __attribute__((ext_vector_type(8))) short bf16x8;
typedef __attribute__((ext_vector_type(16))) float f32x16;

#define DI __device__ __forceinline__
#define MFMA32(a, b, c) __builtin_amdgcn_mfma_f32_32x32x16_bf16((a), (b), (c), 0, 0, 0)

constexpr int NTOK = 16384, SEQ = 4096, NB = 4, DM = 1024, DEPTH = 4, NMEM = 256;
constexpr int INW = 9672, WROWS = 9728, PW = 8960;
constexpr int P_AQ = 0, P_AK = 256, P_IQ = 512, P_BQ = 768, P_BK = 1024, P_CQ = 1280, P_CK = 1536, P_DCQ = 1792,
              P_EQ = 2048, P_Z = 2304, P_G = 3584, P_DCKV = 8704, P_IK = 8832, P_KR = 8864;
constexpr float LOG2E = 1.4426950408889634f;
constexpr float DN_ALPHA = 1.681792830507429f;
constexpr size_t SC_PB = 1024ull * 8256ull;

constexpr size_t OFF_HB = 0;
constexpr size_t OFF_WINT = OFF_HB + (size_t)NTOK * 1024 * 2;
constexpr size_t OFF_WBT = OFF_WINT + (size_t)WROWS * 1024 * 2;
constexpr size_t OFF_WOT = OFF_WBT + (size_t)DEPTH * 5 * 1024 * 256 * 2;
constexpr size_t OFF_WUQT = OFF_WOT + (size_t)DEPTH * 1024 * 1024 * 2;
constexpr size_t OFF_WUKVT = OFF_WUQT + (size_t)DEPTH * 384 * 256 * 2;
constexpr size_t OFF_WMKVT = OFF_WUKVT + (size_t)DEPTH * 512 * 128 * 2;
constexpr size_t OFF_MEMB = OFF_WMKVT + (size_t)DEPTH * 512 * 1024 * 2;
constexpr size_t OFF_MK = OFF_MEMB + (size_t)1024 * 1024 * 2;
constexpr size_t OFF_VTM = OFF_MK + (size_t)DEPTH * 1024 * 256 * 2;
constexpr size_t OFF_P = OFF_VTM + (size_t)DEPTH * 1024 * 256 * 2;
constexpr size_t OFF_VTA = OFF_P + (size_t)NTOK * PW * 2;
constexpr size_t VT_SZ = (size_t)NB * 4 * 64 * SEQ * 2;
constexpr size_t OFF_VTB = OFF_VTA + VT_SZ;
constexpr size_t OFF_VTC = OFF_VTB + VT_SZ;
constexpr size_t OFF_VTD = OFF_VTC + VT_SZ;
constexpr size_t OFF_IW = OFF_VTD + VT_SZ;
constexpr size_t OFF_QF = OFF_IW + (size_t)NTOK * 8 * 4;
constexpr size_t OFF_KN = OFF_QF + (size_t)NTOK * 384 * 2;
constexpr size_t OFF_KBAR = OFF_KN + (size_t)NTOK * 256 * 2;
constexpr size_t OFF_SC = OFF_KBAR + (size_t)NB * 4 * 32 * 64 * 2;
constexpr size_t OFF_Y = OFF_SC;
constexpr size_t OFF_MERGED = OFF_Y + (size_t)NTOK * 1280 * 2;
constexpr size_t OFF_MASK = OFF_SC + (size_t)NB * SC_PB * 4;
constexpr size_t OFF_ROPE = OFF_MASK + (size_t)NTOK * 128 * 4;
constexpr size_t OFF_BAR = OFF_ROPE + (size_t)SEQ * 56 * 4;
constexpr size_t WS_TOTAL = OFF_BAR + 16384;
constexpr int R_CS64 = 0, R_SN64 = SEQ * 8, R_CS32 = SEQ * 16, R_SN32 = SEQ * 20, R_CSM = SEQ * 24, R_SNM = SEQ * 40;

struct Params {
  const float *x, *mem, *ln0_g, *ln0_b, *w_in, *mla_q_norm, *w_uq, *mla_kv_norm, *w_ukv, *diff_lam, *diff_norm,
      *w_mem_kv, *w_branch, *w_out, *ln_g, *ln_b;
  float* out;
  char* ws;
};

typedef float f32x2_t __attribute__((ext_vector_type(2)));
typedef __bf16 bf16x2_t __attribute__((ext_vector_type(2)));
typedef uint32_t u32x4_t __attribute__((ext_vector_type(4)));
DI bf16 f2bf(float x) { return __builtin_bit_cast(bf16, (__bf16)x); }
DI float bf2f(bf16 v) { return __uint_as_float(((uint32_t)v) << 16); }
DI uint32_t pack2(float a, float b) { f32x2_t v = {a, b}; return __builtin_bit_cast(uint32_t, __builtin_convertvector(v, bf16x2_t)); }
DI bf16x8 pack8(const f32x16& x, int o) {
  u32x4_t w;
  w[0] = pack2(x[o], x[o + 1]); w[1] = pack2(x[o + 2], x[o + 3]); w[2] = pack2(x[o + 4], x[o + 5]); w[3] = pack2(x[o + 6], x[o + 7]);
  return __builtin_bit_cast(bf16x8, w);
}
DI int crow(int i, int h) { return (i & 3) + 8 * (i >> 2) + 4 * h; }
DI int pi_perm(int r) { return (r & 0x13) | ((r & 4) << 1) | ((r & 8) >> 1); }
DI int keyidx(int i, int h) { return (i & 3) + 4 * ((i >> 2) & 1) + 8 * h + 16 * (i >> 3); }
DI float fexp2(float x) { return __builtin_amdgcn_exp2f(x); }
DI bf16x8 ldg8(const bf16* p) { return *(const bf16x8*)p; }
DI f32x16 zero16() { f32x16 z; for (int i = 0; i < 16; ++i) z[i] = 0.f; return z; }

struct GStage { uint4 a0, a1, a2, a3, b0, b1, b2, b3; };
DI GStage gemm_issue(const bf16* __restrict__ A, int lda, const bf16* __restrict__ Bt, int ldb, int koff, int tid) {
  GStage g;
  const int srow = tid >> 3, sc = tid & 7;
  const bf16* ga = A + (size_t)srow * lda + sc * 8 + koff;
  const bf16* gb = Bt + (size_t)srow * ldb + sc * 8 + koff;
  const size_t sa32 = (size_t)32 * lda, sb32 = (size_t)32 * ldb;
  g.a0 = *(const uint4*)(ga); g.a1 = *(const uint4*)(ga + sa32); g.a2 = *(const uint4*)(ga + 2 * sa32); g.a3 = *(const uint4*)(ga + 3 * sa32);
  g.b0 = *(const uint4*)(gb); g.b1 = *(const uint4*)(gb + sb32); g.b2 = *(const uint4*)(gb + 2 * sb32); g.b3 = *(const uint4*)(gb + 3 * sb32);
  return g;
}
DI void gemm_stage(char* base, int soff, const GStage& g) {
  *(uint4*)(base + soff) = g.a0; *(uint4*)(base + soff + 4096) = g.a1; *(uint4*)(base + soff + 8192) = g.a2; *(uint4*)(base + soff + 12288) = g.a3;
  *(uint4*)(base + 16384 + soff) = g.b0; *(uint4*)(base + 16384 + soff + 4096) = g.b1;
  *(uint4*)(base + 16384 + soff + 8192) = g.b2; *(uint4*)(base + 16384 + soff + 12288) = g.b3;
}
DI void gemm_core(const bf16* __restrict__ A, int lda, const bf16* __restrict__ Bt, int ldb, int K,
                  f32x16 (&acc)[2][2], char* smem, int& tid_io, GStage g) {
  const int tid = tid_io;
  const int lane = tid & 63, wave = tid >> 6, wm = wave >> 1, wn = wave & 1;
  const int r = lane & 31, h = lane >> 5;
  const int srow = tid >> 3, sc = tid & 7;
  const int soff = srow * 128 + ((sc ^ ((srow >> 1) & 7)) << 4);
  const int KT = K >> 6;
  const int swz = (r >> 1) & 7;
  const int aoff = (wm * 64 + r) * 128, boff = 16384 + (wn * 64 + r) * 128;
  gemm_stage(smem, soff, g);
  __syncthreads();
#pragma unroll 1
  for (int kt = 0; kt < KT; ++kt) {
    if (kt + 1 < KT) g = gemm_issue(A, lda, Bt, ldb, (kt + 1) * 64, tid);
    const char* sbase = smem + (kt & 1) * 32768;
#pragma unroll
    for (int hh = 0; hh < 2; ++hh) {
      bf16x8 fa[2][2], fb[2][2];
#pragma unroll
      for (int k2 = 0; k2 < 2; ++k2) {
        const int co = (((hh * 2 + k2) * 2 + h) ^ swz) << 4;
        fa[k2][0] = *(const bf16x8*)(sbase + aoff + co);
        fb[k2][0] = *(const bf16x8*)(sbase + boff + co);
        fb[k2][1] = *(const bf16x8*)(sbase + boff + 4096 + co);
        fa[k2][1] = *(const bf16x8*)(sbase + aoff + 4096 + co);
      }
      __builtin_amdgcn_sched_barrier(0);
#pragma unroll
      for (int k2 = 0; k2 < 2; ++k2) {
        acc[0][0] = MFMA32(fa[k2][0], fb[k2][0], acc[0][0]);
        acc[0][1] = MFMA32(fa[k2][0], fb[k2][1], acc[0][1]);
        acc[1][0] = MFMA32(fa[k2][1], fb[k2][0], acc[1][0]);
        acc[1][1] = MFMA32(fa[k2][1], fb[k2][1], acc[1][1]);
      }
      __builtin_amdgcn_sched_barrier(0);
    }
    if (kt + 1 < KT) gemm_stage(smem + ((kt + 1) & 1) * 32768, soff, g);
    __syncthreads();
  }
  asm volatile("" : "+v"(tid_io) : : "memory");
}
template <int KT>
DI void gemm_core_u(const bf16* __restrict__ A, int lda, const bf16* __restrict__ Bt, int ldb,
                    f32x16 (&acc)[2][2], char* smem, int& tid_io, GStage g0) {
  const int tid = tid_io;
  const int lane = tid & 63, wave = tid >> 6, wm = wave >> 1, wn = wave & 1;
  const int r = lane & 31, h = lane >> 5;
  const int srow = tid >> 3, sc = tid & 7;
  const int soff = srow * 128 + ((sc ^ ((srow >> 1) & 7)) << 4);
  const int swz = (r >> 1) & 7;
  const int aoff = (wm * 64 + r) * 128, boff = 16384 + (wn * 64 + r) * 128;
  GStage gs[2];
  gs[0] = g0;
  gs[1] = gemm_issue(A, lda, Bt, ldb, 64, tid);
  gemm_stage(smem, soff, gs[0]);
  if (KT > 2) gs[0] = gemm_issue(A, lda, Bt, ldb, 128, tid);
  __syncthreads();
  bf16x8 xa0, xa1, xb0, xb1, ya0, ya1, yb0, yb1;
#define RDF(S, sb, q)                                                       \
  {                                                                         \
    const int co_ = (((q) * 2 + h) ^ swz) << 4;                             \
    S##a0 = *(const bf16x8*)((sb) + aoff + co_);                            \
    S##b0 = *(const bf16x8*)((sb) + boff + co_);                            \
    S##b1 = *(const bf16x8*)((sb) + boff + 4096 + co_);                     \
    S##a1 = *(const bf16x8*)((sb) + aoff + 4096 + co_);                     \
  }
#define MMF(S)                                                              \
  acc[0][0] = MFMA32(S##a0, S##b0, acc[0][0]);                              \
  acc[0][1] = MFMA32(S##a0, S##b1, acc[0][1]);                              \
  acc[1][0] = MFMA32(S##a1, S##b0, acc[1][0]);                              \
  acc[1][1] = MFMA32(S##a1, S##b1, acc[1][1]);
#define SB __builtin_amdgcn_sched_barrier(0);
  RDF(x, smem, 0)
#pragma unroll
  for (int kt = 0; kt < KT; ++kt) {
    const char* sbase = smem + (kt & 1) * 32768;
    SB RDF(y, sbase, 1) SB MMF(x) SB
    RDF(x, sbase, 2) SB MMF(y) SB
    RDF(y, sbase, 3) SB MMF(x) SB
    if (kt + 1 < KT) {
      gemm_stage(smem + ((kt + 1) & 1) * 32768, soff, gs[(kt + 1) & 1]);
      if (kt + 3 < KT) gs[(kt + 1) & 1] = gemm_issue(A, lda, Bt, ldb, (kt + 3) * 64, tid);
    }
    SB MMF(y) SB
    __syncthreads();
    if (kt + 1 < KT) { RDF(x, smem + ((kt + 1) & 1) * 32768, 0) }
  }
#undef RDF
#undef MMF
#undef SB
  asm volatile("" : "+v"(tid_io) : : "memory");
}
DI void gemm_full_loop(const bf16* __restrict__ A, int lda, const bf16* __restrict__ Bt, int ldb, int K,
                       f32x16 (&acc)[2][2], char* smem, int& tid_io) {
  GStage g = gemm_issue(A, lda, Bt, ldb, 0, tid_io);
  gemm_core(A, lda, Bt, ldb, K, acc, smem, tid_io, g);
}
template <int KT>
DI void gemm_full(const bf16* __restrict__ A, int lda, const bf16* __restrict__ Bt, int ldb,
                  f32x16 (&acc)[2][2], char* smem, int& tid_io) {
  GStage g = gemm_issue(A, lda, Bt, ldb, 0, tid_io);
  gemm_core_u<KT>(A, lda, Bt, ldb, acc, smem, tid_io, g);
}

DI void store_rm(bf16* dst, int ld, int rowb, int col, const f32x16& v, int h) {
#pragma unroll
  for (int i = 0; i < 16; ++i) dst[(size_t)(rowb + crow(i, h)) * ld + col] = f2bf(v[i]);
}
DI void store_vt(bf16* vt, int tstride, int d, int t0, const f32x16& v, int h) {
#pragma unroll
  for (int g = 0; g < 4; ++g) {
    uint2 w;
    w.x = pack2(v[4 * g], v[4 * g + 1]);
    w.y = pack2(v[4 * g + 2], v[4 * g + 3]);
    *(uint2*)(vt + (size_t)d * tstride + t0 + 8 * g + 4 * h) = w;
  }
}
template <int XR>
DI void rope_tile(f32x16& v, int r, int h, int rowb, const float* cs, const float* sn) {
  const int f = r & (XR - 1);
  const int tb = (rowb & (SEQ - 1)) + 4 * h;
#pragma unroll
  for (int i = 0; i < 16; ++i) {
    float pv = __shfl_xor(v[i], XR);
    if (r < 2 * XR) {
      const int idx = (tb + (i & 3) + 8 * (i >> 2)) * XR + f;
      float c = cs[idx], s = sn[idx];
      v[i] = (r < XR) ? (v[i] * c - pv * s) : (v[i] * c + pv * s);
    }
  }
}

DI void ln_rows(const float* src, const float* g, const float* b, float* dstf, bf16* dstb, int tid) {
  const int lane = tid & 63, wave = tid >> 6;
  for (int row = blockIdx.x * 4 + wave; row < NTOK; row += gridDim.x * 4) {
    const float4* s4 = (const float4*)(src + (size_t)row * DM);
    float4 v[4];
    float sum = 0.f;
#pragma unroll
    for (int j = 0; j < 4; ++j) { v[j] = s4[lane + 64 * j]; sum += v[j].x + v[j].y + v[j].z + v[j].w; }
#pragma unroll
    for (int o = 32; o >= 1; o >>= 1) sum += __shfl_xor(sum, o);
    float mu = sum * (1.f / DM);
    float sq = 0.f;
#pragma unroll
    for (int j = 0; j < 4; ++j) {
      float a = v[j].x - mu, bb = v[j].y - mu, c = v[j].z - mu, d = v[j].w - mu;
      sq += a * a + bb * bb + c * c + d * d;
    }
#pragma unroll
    for (int o = 32; o >= 1; o >>= 1) sq += __shfl_xor(sq, o);
    float rstd = rsqrtf(sq * (1.f / DM) + 1e-5f);
#pragma unroll
    for (int j = 0; j < 4; ++j) {
      int c0 = (lane + 64 * j) * 4;
      float4 gg = *(const float4*)(g + c0), bb = *(const float4*)(b + c0);
      float4 o;
      o.x = (v[j].x - mu) * rstd * gg.x + bb.x;
      o.y = (v[j].y - mu) * rstd * gg.y + bb.y;
      o.z = (v[j].z - mu) * rstd * gg.z + bb.z;
      o.w = (v[j].w - mu) * rstd * gg.w + bb.w;
      *(float4*)(dstf + (size_t)row * DM + c0) = o;
      if (dstb) {
        uint2 w; w.x = pack2(o.x, o.y); w.y = pack2(o.z, o.w);
        *(uint2*)(dstb + (size_t)row * DM + c0) = w;
      }
    }
  }
}

DI int wcol_of(int n) {
  if (n < 1024) return n;
  if (n < 1056) return 9600 + (n - 1024);
  if (n < 1064) return 9664 + (n - 1056);
  if (n < 2600) return n - 40;
  if (n < 2856) return n - 2600 + 2560;
  if (n < 2984) return n - 2856 + 9472;
  if (n < 3016) return n - 2984 + 9632;
  if (n < 3272) return n - 3016 + 2816;
  return n - 200;
}

template <bool MAPW>
DI void conv_tile(const float* src, int K, int N, bf16* dst, const float* rowscale, char* smem, int tid, int t) {
  float* lds = (float*)smem;
  const int ktiles = K >> 6;
  const int k0 = (t % ktiles) * 64, n0 = (t / ktiles) * 64;
  const int tx = (tid & 15) * 4, ty = tid >> 4;
  float4 v[4];
#pragma unroll
  for (int i = 0; i < 4; ++i) {
    const int k = ty + 16 * i;
    v[i] = (n0 + tx < N) ? *(const float4*)(src + (size_t)(k0 + k) * N + n0 + tx) : make_float4(0.f, 0.f, 0.f, 0.f);
  }
#pragma unroll
  for (int i = 0; i < 4; ++i) {
    const int k = ty + 16 * i;
    const float rsc = rowscale ? rowscale[k0 + k] : 1.f;
    lds[k * 65 + tx] = v[i].x * rsc; lds[k * 65 + tx + 1] = v[i].y * rsc;
    lds[k * 65 + tx + 2] = v[i].z * rsc; lds[k * 65 + tx + 3] = v[i].w * rsc;
  }
  __syncthreads();
  const int nl = tid >> 2, kc = tid & 3;
  if (n0 + nl < N) {
    const int nd = MAPW ? wcol_of(n0 + nl) : (n0 + nl);
    uint32_t w[8];
#pragma unroll
    for (int jj = 0; jj < 8; ++jj) w[jj] = pack2(lds[(kc * 16 + 2 * jj) * 65 + nl], lds[(kc * 16 + 2 * jj + 1) * 65 + nl]);
    uint4* d4 = (uint4*)(dst + (size_t)nd * K + k0 + kc * 16);
    d4[0] = make_uint4(w[0], w[1], w[2], w[3]);
    d4[1] = make_uint4(w[4], w[5], w[6], w[7]);
  }
  __syncthreads();
}
template <bool MAPW>
DI void conv_matrix(const float* src, int K, int N, bf16* dst, const float* rowscale, char* smem, int tid) {
  const int ntl = (K >> 6) * ((N + 63) >> 6);
  for (int t = blockIdx.x; t < ntl; t += gridDim.x) conv_tile<MAPW>(src, K, N, dst, rowscale, smem, tid, t);
}

DI void st8(bf16* dst, const float (&x)[8]) {
  uint4 w;
  w.x = pack2(x[0], x[1]); w.y = pack2(x[2], x[3]); w.z = pack2(x[4], x[5]); w.w = pack2(x[6], x[7]);
  *(uint4*)dst = w;
}
DI void ld8(const float* src, float (&x)[8]) {
  float4 a = *(const float4*)src, b = *(const float4*)(src + 4);
  x[0] = a.x; x[1] = a.y; x[2] = a.z; x[3] = a.w; x[4] = b.x; x[5] = b.y; x[6] = b.z; x[7] = b.w;
}
DI void epi_inproj(const Params& p, f32x16 (&acc)[2][2], int mt, int ct, int tid, char* smem) {
  float* C = (float*)smem;
  {
    const int lane = tid & 63, wave = tid >> 6, wm = wave >> 1, wn = wave & 1, r = lane & 31, h = lane >> 5;
#pragma unroll
    for (int mi = 0; mi < 2; ++mi)
#pragma unroll
      for (int ni = 0; ni < 2; ++ni)
#pragma unroll
        for (int i = 0; i < 16; ++i)
          C[(wm * 64 + mi * 32 + crow(i, h)) * 128 + wn * 64 + ni * 32 + r] = acc[mi][ni][i];
  }
  __syncthreads();
  bf16* P = (bf16*)(p.ws + OFF_P);
  const float* rope = (const float*)(p.ws + OFF_ROPE);
  const int m0 = mt * 128;
  const int seg = ct >> 1;
  if (ct < 24 && (seg == 2 || seg == 6 || seg == 9)) {
    const size_t off = seg == 2 ? OFF_VTA : (seg == 6 ? OFF_VTB : OFF_VTC);
    const int col = tid & 127;
    const int cs = (ct & 1) * 128 + col;
    bf16* vt = (bf16*)(p.ws + off) + ((size_t)((m0 >> 12) * 4 + (cs >> 6)) * 64 + (cs & 63)) * SEQ + (m0 & (SEQ - 1));
#pragma unroll
    for (int ps = 0; ps < 8; ++ps) {
      const int rg = (tid >> 7) + 2 * ps;
      float x[8];
#pragma unroll
      for (int e = 0; e < 8; ++e) x[e] = C[(rg * 8 + e) * 128 + col];
      st8(vt + rg * 8, x);
    }
  } else {
    const int c0 = (tid & 15) * 8;
    int mode, pcol;
    if (ct < 24) {
      switch (seg) {
        case 0: pcol = P_AQ; mode = 1; break;  case 1: pcol = P_AK; mode = 1; break;
        case 3: pcol = P_IQ; mode = 2; break;  case 4: pcol = P_BQ; mode = 1; break;
        case 5: pcol = P_BK; mode = 1; break;  case 7: pcol = P_CQ; mode = 2; break;
        case 8: pcol = P_CK; mode = 2; break;  case 10: pcol = P_DCQ; mode = 0; break;
        default: pcol = P_EQ; mode = 0; break;
      }
      pcol += (ct & 1) * 128;
    } else if (ct < 34) { mode = 3; pcol = P_Z + (ct - 24) * 128; }
    else if (ct < 74) { mode = 4; pcol = P_G + (ct - 34) * 128; }
    else if (ct == 74) { mode = 0; pcol = P_DCKV; }
    else { mode = 5; pcol = P_IK; }
#pragma unroll 1
    for (int ps = 0; ps < 8; ++ps) {
      const int row = ps * 16 + (tid >> 4);
      const int t = (m0 + row) & (SEQ - 1);
      float x[8];
      ld8(C + row * 128 + c0, x);
      bf16* dst = P + (size_t)(m0 + row) * PW + pcol + c0;
      if (mode == 3) {
#pragma unroll
        for (int e = 0; e < 8; ++e) x[e] = x[e] * __builtin_amdgcn_rcpf(1.f + __expf(-x[e]));
      } else if (mode == 4) {
#pragma unroll
        for (int e = 0; e < 8; ++e) x[e] = __builtin_amdgcn_rcpf(1.f + __expf(-x[e]));
      } else if (mode == 1) {
        const int hc = c0 & 63;
        if (hc < 16) {
          float y[8], c[8], sn[8];
          ld8(C + row * 128 + (c0 ^ 8), y);
          ld8(rope + R_CS64 + t * 8, c);
          ld8(rope + R_SN64 + t * 8, sn);
#pragma unroll
          for (int e = 0; e < 8; ++e) x[e] = (hc == 0) ? (x[e] * c[e] - y[e] * sn[e]) : (x[e] * c[e] + y[e] * sn[e]);
        }
      } else if (mode == 2 || (mode == 5 && c0 == 0)) {
        if ((c0 & 31) == 0) {
          float4 c = *(const float4*)(rope + R_CS32 + t * 4), sn = *(const float4*)(rope + R_SN32 + t * 4);
          float a0 = x[0], a1 = x[1], a2 = x[2], a3 = x[3], b0 = x[4], b1 = x[5], b2 = x[6], b3 = x[7];
          x[0] = a0 * c.x - b0 * sn.x; x[1] = a1 * c.y - b1 * sn.y; x[2] = a2 * c.z - b2 * sn.z; x[3] = a3 * c.w - b3 * sn.w;
          x[4] = b0 * c.x + a0 * sn.x; x[5] = b1 * c.y + a1 * sn.y; x[6] = b2 * c.z + a2 * sn.z; x[7] = b3 * c.w + a3 * sn.w;
        }
      } else if (mode == 5) {
        if (c0 >= 32 && c0 < 64) {
          const int hc = c0 - 32;
          float y[8], c[8], sn[8];
          ld8(C + row * 128 + 32 + (hc ^ 16), y);
          ld8(rope + R_CSM + t * 16 + (hc & 15), c);
          ld8(rope + R_SNM + t * 16 + (hc & 15), sn);
#pragma unroll
          for (int e = 0; e < 8; ++e) x[e] = (hc < 16) ? (x[e] * c[e] - y[e] * sn[e]) : (x[e] * c[e] + y[e] * sn[e]);
        }
      }
      if (mode != 5 || c0 < 64) {
        st8(dst, x);
      } else if (c0 == 64) {
        float* iw = (float*)(p.ws + OFF_IW) + (size_t)(m0 + row) * 8;
        *(float4*)iw = make_float4(x[0], x[1], x[2], x[3]);
        *(float4*)(iw + 4) = make_float4(x[4], x[5], x[6], x[7]);
      }
    }
  }
  __syncthreads();
}

struct AttnArgs {
  const bf16* Q; int qs;
  const bf16* K1; int k1s;
  const bf16* K2; int k2s;
  const bf16* Vt; int vts;
  int q0;
  float sc;
  const uint32_t* mask;
  const bf16* kbar;
};

#ifndef ZERO_BR
#define ZERO_BR -1
#endif
DI void attn_store(const Params& p, const f32x16 (&o)[2], float inv, int row, int br, int head, int lane) {
  const int h = lane >> 5;
  if (br == ZERO_BR) inv = 0.f;
  const bf16* P = (const bf16*)(p.ws + OFF_P);
  bf16* Y = (bf16*)(p.ws + OFF_Y);
#pragma unroll
  for (int dt = 0; dt < 2; ++dt)
#pragma unroll
    for (int g = 0; g < 4; ++g) {
      int d0 = dt * 32 + 8 * g + 4 * h;
      int c = br * 256 + head * 64 + d0;
      uint2 zz = *(const uint2*)(P + (size_t)row * PW + P_Z + c);
      float z0 = bf2f((bf16)(zz.x & 0xffff)), z1 = bf2f((bf16)(zz.x >> 16));
      float z2 = bf2f((bf16)(zz.y & 0xffff)), z3 = bf2f((bf16)(zz.y >> 16));
      uint2 w;
      w.x = pack2(o[dt][4 * g] * inv * z0, o[dt][4 * g + 1] * inv * z1);
      w.y = pack2(o[dt][4 * g + 2] * inv * z2, o[dt][4 * g + 3] * inv * z3);
      *(uint2*)(Y + (size_t)row * 1280 + c) = w;
    }
}

DI float xh_max(float v) {
  auto rr = __builtin_amdgcn_permlane32_swap(__float_as_uint(v), __float_as_uint(v), false, false);
  return fmaxf(__uint_as_float(rr[0]), __uint_as_float(rr[1]));
}
DI float xh_sum(float v) {
  auto rr = __builtin_amdgcn_permlane32_swap(__float_as_uint(v), __float_as_uint(v), false, false);
  return __uint_as_float(rr[0]) + __uint_as_float(rr[1]);
}
template <int MODE, int NKS1, int NKS2>
DI void attn_std(const Params& p, const AttnArgs& a, int ntiles, int lane, int br, int head, int rowbase) {
  f32x16 o[2][2];
  constexpr int NKS = NKS1 + NKS2;
  const int r = lane & 31, h = lane >> 5;
  bf16x8 qf[2][NKS];
#pragma unroll
  for (int qi = 0; qi < 2; ++qi)
#pragma unroll
    for (int ks = 0; ks < NKS; ++ks) qf[qi][ks] = ldg8(a.Q + (size_t)(a.q0 + 32 * qi + r) * a.qs + ks * 16 + 8 * h);
  float m[2] = {-INFINITY, -INFINITY}, l[2] = {0.f, 0.f};
#pragma unroll
  for (int qi = 0; qi < 2; ++qi) { o[qi][0] = zero16(); o[qi][1] = zero16(); }
  const int pr = pi_perm(r);
  uint32_t selmask[2] = {0u, 0u};
  const int own = a.q0 >> 8;
  uint32_t blkmask = 0xffffffffu;
  if (MODE == 3) {
    bf16x8 kbf[4];
#pragma unroll
    for (int ks = 0; ks < 4; ++ks) kbf[ks] = ldg8(a.kbar + (size_t)(r & 15) * 64 + ks * 16 + 8 * h);
    blkmask = 1u << own;
#pragma unroll
    for (int qi = 0; qi < 2; ++qi) {
      f32x16 g = zero16();
#pragma unroll
      for (int ks = 0; ks < 4; ++ks) g = MFMA32(kbf[ks], qf[qi][ks], g);
      float mine[8], part[8];
#pragma unroll
      for (int i = 0; i < 8; ++i) { mine[i] = g[i]; part[i] = __shfl_xor(g[i], 32); }
      uint32_t sm = 0u;
#pragma unroll
      for (int it = 0; it < 3; ++it) {
        float best = -INFINITY; int bi = -1;
#pragma unroll
        for (int n = 0; n < 16; ++n) {
          const int i = (n & 3) + 4 * (n >> 3);
          float gv = (((n >> 2) & 1) == h) ? mine[i] : part[i];
          bool ok = (n < own) && !((sm >> n) & 1u) && (gv > best);
          if (ok) { best = gv; bi = n; }
        }
        if (bi >= 0) sm |= 1u << bi;
      }
      selmask[qi] = sm;
#pragma unroll
      for (int n = 0; n < 16; ++n)
        if (__ballot((sm >> n) & 1u) != 0ull) blkmask |= 1u << n;
    }
  }
  auto advance = [&](int kt) {
    ++kt;
    if (MODE == 3) { while (kt < ntiles && !((blkmask >> (kt >> 3)) & 1u)) kt = (kt | 7) + 1; }
    return kt;
  };
  bf16x8 kf[NKS];
  uint32_t mw[2] = {0u, 0u};
  int kt = advance(-1);
  {
    const int key = kt * 32 + pr;
#pragma unroll
    for (int ks = 0; ks < NKS1; ++ks) kf[ks] = ldg8(a.K1 + (size_t)key * a.k1s + ks * 16 + 8 * h);
#pragma unroll
    for (int ks = 0; ks < NKS2; ++ks) kf[NKS1 + ks] = ldg8(a.K2 + (size_t)key * a.k2s + ks * 16 + 8 * h);
    if (MODE == 2) { mw[0] = a.mask[(size_t)(a.q0 + r) * 128 + kt]; mw[1] = a.mask[(size_t)(a.q0 + 32 + r) * 128 + kt]; }
  }
  while (kt < ntiles) {
    const int nxt = advance(kt);
    const int ktn = nxt < ntiles ? nxt : kt;
    bf16x8 kfn[NKS], vf[2][2];
    uint32_t mwn[2] = {0u, 0u};
    {
      const int key = ktn * 32 + pr;
#pragma unroll
      for (int ks = 0; ks < NKS1; ++ks) kfn[ks] = ldg8(a.K1 + (size_t)key * a.k1s + ks * 16 + 8 * h);
#pragma unroll
      for (int ks = 0; ks < NKS2; ++ks) kfn[NKS1 + ks] = ldg8(a.K2 + (size_t)key * a.k2s + ks * 16 + 8 * h);
#pragma unroll
      for (int s = 0; s < 2; ++s)
#pragma unroll
        for (int dt = 0; dt < 2; ++dt) vf[s][dt] = ldg8(a.Vt + (size_t)(dt * 32 + r) * a.vts + kt * 32 + 16 * s + 8 * h);
      if (MODE == 2) { mwn[0] = a.mask[(size_t)(a.q0 + r) * 128 + ktn]; mwn[1] = a.mask[(size_t)(a.q0 + 32 + r) * 128 + ktn]; }
    }
#pragma unroll
    for (int qi = 0; qi < 2; ++qi) {
      const int qd = (a.q0 >> 5) + qi;
      if (MODE != 1 && kt > qd) continue;
      bool lane_ok = true;
      if (MODE == 3) {
        const int jb = kt >> 3;
        if (jb < own) lane_ok = (selmask[qi] >> jb) & 1u;
      }
      f32x16 sacc = zero16();
#pragma unroll
      for (int ks = 0; ks < NKS; ++ks) sacc = MFMA32(kf[ks], qf[qi][ks], sacc);
      const bool diag = (MODE == 0 || MODE == 3) && (kt == qd);
      float mloc = -INFINITY;
      if (MODE == 2 || diag || (MODE == 3 && (kt >> 3) < own)) {
#pragma unroll
        for (int i = 0; i < 16; ++i) {
          bool ok = lane_ok;
          if (diag) ok = ok && (keyidx(i, h) <= r);
          if (MODE == 2) ok = (mw[qi] >> keyidx(i, h)) & 1u;
          float sv = ok ? sacc[i] : -INFINITY;
          sacc[i] = sv;
          mloc = fmaxf(mloc, sv);
        }
      } else {
#pragma unroll
        for (int i = 0; i < 16; ++i) mloc = fmaxf(mloc, sacc[i]);
      }
      mloc = xh_max(mloc) * a.sc;
      const float mnew = fmaxf(m[qi], mloc);
      const float muse = (mnew == -INFINITY) ? 0.f : mnew;
      const float alpha = fexp2(m[qi] - muse);
      m[qi] = mnew;
      float psum = 0.f;
#pragma unroll
      for (int i = 0; i < 16; ++i) { float pv = fexp2(fmaf(sacc[i], a.sc, -muse)); sacc[i] = pv; psum += pv; }
      l[qi] = l[qi] * alpha + psum;
      if (__ballot(alpha != 1.f) != 0ull) {
#pragma unroll
        for (int i = 0; i < 16; ++i) { o[qi][0][i] *= alpha; o[qi][1][i] *= alpha; }
      }
#pragma unroll
      for (int s = 0; s < 2; ++s) {
        const bf16x8 pf = pack8(sacc, 8 * s);
        o[qi][0] = MFMA32(vf[s][0], pf, o[qi][0]);
        o[qi][1] = MFMA32(vf[s][1], pf, o[qi][1]);
      }
    }
#pragma unroll
    for (int ks = 0; ks < NKS; ++ks) kf[ks] = kfn[ks];
    mw[0] = mwn[0]; mw[1] = mwn[1];
    kt = nxt;
  }
  attn_store(p, o[0], 1.f / xh_sum(l[0]), rowbase + a.q0 + r, br, head, lane);
  attn_store(p, o[1], 1.f / xh_sum(l[1]), rowbase + a.q0 + 32 + r, br, head, lane);
}

DI void attn_diff(const Params& p, int layer, int b, int head, int q0, int lane) {
  const int r = lane & 31, h = lane >> 5;
  const bf16* P = (const bf16*)(p.ws + OFF_P);
  const bf16* Qb = P + (size_t)b * SEQ * PW + P_CQ + head * 64;
  const bf16* Kb = P + (size_t)b * SEQ * PW + P_CK + head * 64;
  const bf16* Vt = (const bf16*)(p.ws + OFF_VTC) + (size_t)(b * 4 + head) * 64 * SEQ;
  const int q = q0 + r;
  bf16x8 qf[4];
#pragma unroll
  for (int ks = 0; ks < 4; ++ks) qf[ks] = ldg8(Qb + (size_t)q * PW + ks * 16 + 8 * h);
  f32x16 o1[2], o2[2];
  o1[0] = zero16(); o1[1] = zero16(); o2[0] = zero16(); o2[1] = zero16();
  float m1 = -INFINITY, l1 = 0.f, m2 = -INFINITY, l2 = 0.f;
  const float sc = 0.17677669529663687f * LOG2E;
  const int pr = pi_perm(r);
  const int ntiles = (q0 >> 5) + 1;
  bf16x8 kf[4], vf[2][2];
  {
    const int key = pr;
#pragma unroll
    for (int ks = 0; ks < 4; ++ks) kf[ks] = ldg8(Kb + (size_t)key * PW + ks * 16 + 8 * h);
#pragma unroll
    for (int s = 0; s < 2; ++s)
#pragma unroll
      for (int dt = 0; dt < 2; ++dt) vf[s][dt] = ldg8(Vt + (size_t)(dt * 32 + r) * SEQ + 16 * s + 8 * h);
  }
  for (int kt = 0; kt < ntiles; ++kt) {
    const int ktn = (kt + 1 < ntiles) ? kt + 1 : kt;
    bf16x8 kfn[4], vfn[2][2];
    {
      const int key = ktn * 32 + pr;
#pragma unroll
      for (int ks = 0; ks < 4; ++ks) kfn[ks] = ldg8(Kb + (size_t)key * PW + ks * 16 + 8 * h);
#pragma unroll
      for (int s = 0; s < 2; ++s)
#pragma unroll
        for (int dt = 0; dt < 2; ++dt) vfn[s][dt] = ldg8(Vt + (size_t)(dt * 32 + r) * SEQ + ktn * 32 + 16 * s + 8 * h);
    }
    f32x16 s1 = zero16(), s2 = zero16();
    s1 = MFMA32(kf[0], qf[0], s1); s1 = MFMA32(kf[1], qf[1], s1);
    s2 = MFMA32(kf[2], qf[2], s2); s2 = MFMA32(kf[3], qf[3], s2);
    const bool diag = (kt == ntiles - 1);
    float ml1 = -INFINITY, ml2 = -INFINITY;
#pragma unroll
    for (int i = 0; i < 16; ++i) {
      bool ok = !diag || (keyidx(i, h) <= r);
      float a = ok ? s1[i] * sc : -INFINITY, c = ok ? s2[i] * sc : -INFINITY;
      s1[i] = a; s2[i] = c;
      ml1 = fmaxf(ml1, a); ml2 = fmaxf(ml2, c);
    }
    ml1 = xh_max(ml1);
    ml2 = xh_max(ml2);
    float mn1 = fmaxf(m1, ml1), mn2 = fmaxf(m2, ml2);
    float al1 = fexp2(m1 - mn1), al2 = fexp2(m2 - mn2);
    m1 = mn1; m2 = mn2;
    float ps1 = 0.f, ps2 = 0.f;
#pragma unroll
    for (int i = 0; i < 16; ++i) {
      float a = fexp2(s1[i] - mn1), c = fexp2(s2[i] - mn2);
      s1[i] = a; s2[i] = c; ps1 += a; ps2 += c;
    }
    l1 = l1 * al1 + ps1; l2 = l2 * al2 + ps2;
    if (__ballot((al1 != 1.f) || (al2 != 1.f)) != 0ull)
#pragma unroll
    for (int i = 0; i < 16; ++i) { o1[0][i] *= al1; o1[1][i] *= al1; o2[0][i] *= al2; o2[1][i] *= al2; }
#pragma unroll
    for (int s = 0; s < 2; ++s) {
      const bf16x8 p1 = pack8(s1, 8 * s), p2 = pack8(s2, 8 * s);
      o1[0] = MFMA32(vf[s][0], p1, o1[0]); o1[1] = MFMA32(vf[s][1], p1, o1[1]);
      o2[0] = MFMA32(vf[s][0], p2, o2[0]); o2[1] = MFMA32(vf[s][1], p2, o2[1]);
    }
#pragma unroll
    for (int ks = 0; ks < 4; ++ks) kf[ks] = kfn[ks];
#pragma unroll
    for (int s = 0; s < 2; ++s) { vf[s][0] = vfn[s][0]; vf[s][1] = vfn[s][1]; }
  }
  l1 = xh_sum(l1); l2 = xh_sum(l2);
  const float* dl = p.diff_lam + (size_t)layer * 128;
  float d01 = dl[r] * dl[32 + r], d23 = dl[64 + r] * dl[96 + r];
#pragma unroll
  for (int off = 16; off >= 1; off >>= 1) { d01 += __shfl_xor(d01, off); d23 += __shfl_xor(d23, off); }
  const float lam_init = 0.8f - 0.6f * expf(-0.3f * (float)layer);
  const float lam = expf(d01) - expf(d23) + lam_init;
  const float i1 = 1.f / l1, i2 = lam / l2;
  float ss = 0.f;
#pragma unroll
  for (int dt = 0; dt < 2; ++dt)
#pragma unroll
    for (int i = 0; i < 16; ++i) { float v = o1[dt][i] * i1 - o2[dt][i] * i2; o1[dt][i] = v; ss += v * v; }
  ss += __shfl_xor(ss, 32);
  const float rs = rsqrtf(ss * (1.f / 64.f) + 1e-6f) * (1.f - lam_init);
  const float* dn = p.diff_norm + (size_t)layer * 64;
#pragma unroll
  for (int dt = 0; dt < 2; ++dt)
#pragma unroll
    for (int i = 0; i < 16; ++i) o1[dt][i] *= dn[dt * 32 + crow(i, h)];
  attn_store(p, o1, rs, b * SEQ + q, 2, head, lane);
}

constexpr int AT_STAGE = 20480;
struct AtRegs { uint4 k0, k1, v0, v1, kr; };

template <int NKS2>
DI AtRegs at_issue(const AttnArgs& a, int kt, int tid) {
  AtRegs g;
  const int row = tid >> 3, c = tid & 7;
  const bf16* kp = a.K1 + (size_t)(kt * 64 + row) * a.k1s + c * 8;
  g.k0 = *(const uint4*)kp;
  g.k1 = *(const uint4*)(kp + (size_t)32 * a.k1s);
  const bf16* vp = a.Vt + (size_t)row * a.vts + kt * 64 + c * 8;
  g.v0 = *(const uint4*)vp;
  g.v1 = *(const uint4*)(vp + (size_t)32 * a.vts);
  if (NKS2) g.kr = *(const uint4*)(a.K2 + (size_t)(kt * 64 + (tid >> 2)) * a.k2s + (tid & 3) * 8);
  else g.kr = make_uint4(0u, 0u, 0u, 0u);
  return g;
}
template <int NKS2>
DI void at_stage(char* st, const AtRegs& g, int tid) {
  const int row = tid >> 3, c = tid & 7;
  const int off = row * 128 + ((c ^ ((row >> 1) & 7)) << 4);
  *(uint4*)(st + off) = g.k0;
  *(uint4*)(st + off + 4096) = g.k1;
  *(uint4*)(st + 8192 + off) = g.v0;
  *(uint4*)(st + 8192 + off + 4096) = g.v1;
  if (NKS2) {
    const int r2 = tid >> 2, c2 = tid & 3;
    *(uint4*)(st + 16384 + r2 * 64 + ((c2 ^ ((r2 >> 2) & 3)) << 4)) = g.kr;
  }
}

template <int MODE, int NKS2>
DI void attn_blk_std(const Params& p, const AttnArgs& a, int nt_none, int tid, int br, int head, int rowbase, char* smem, unsigned* s_blk) {
  constexpr int NKS = 4 + NKS2;
  const int lane = tid & 63, wave = tid >> 6, r = lane & 31, h = lane >> 5;
  const int q0w = a.q0 + wave * 64;
  bf16x8 qf[2][NKS];
#pragma unroll
  for (int qi = 0; qi < 2; ++qi)
#pragma unroll
    for (int ks = 0; ks < NKS; ++ks) qf[qi][ks] = ldg8(a.Q + (size_t)(q0w + 32 * qi + r) * a.qs + ks * 16 + 8 * h);
  f32x16 o[2][2];
  float m[2] = {-INFINITY, -INFINITY}, l[2] = {0.f, 0.f};
#pragma unroll
  for (int qi = 0; qi < 2; ++qi) { o[qi][0] = zero16(); o[qi][1] = zero16(); }
  const int pr = pi_perm(r);
  uint32_t selmask[2] = {0u, 0u};
  uint32_t qmask[2] = {0u, 0u};
  const int own = a.q0 >> 8;
  uint32_t blkmask = 0xffffffffu;
  if (MODE == 3) {
    bf16x8 kbf[4];
#pragma unroll
    for (int ks = 0; ks < 4; ++ks) kbf[ks] = ldg8(a.kbar + (size_t)(r & 15) * 64 + ks * 16 + 8 * h);
    uint32_t wmask = 0u;
#pragma unroll
    for (int qi = 0; qi < 2; ++qi) {
      f32x16 g = zero16();
#pragma unroll
      for (int ks = 0; ks < 4; ++ks) g = MFMA32(kbf[ks], qf[qi][ks], g);
      float mine[8], part[8];
#pragma unroll
      for (int i = 0; i < 8; ++i) { mine[i] = g[i]; part[i] = __shfl_xor(g[i], 32); }
      uint32_t sm = 0u;
#pragma unroll
      for (int it = 0; it < 3; ++it) {
        float best = -INFINITY; int bi = -1;
#pragma unroll
        for (int n = 0; n < 16; ++n) {
          const int i = (n & 3) + 4 * (n >> 3);
          float gv = (((n >> 2) & 1) == h) ? mine[i] : part[i];
          bool ok = (n < own) && !((sm >> n) & 1u) && (gv > best);
          if (ok) { best = gv; bi = n; }
        }
        if (bi >= 0) sm |= 1u << bi;
      }
      selmask[qi] = sm;
      uint32_t um = 0u;
#pragma unroll
      for (int n = 0; n < 16; ++n)
        if (__ballot((sm >> n) & 1u) != 0ull) um |= 1u << n;
      qmask[qi] = um;
      wmask |= um;
    }
    if (tid == 0) *s_blk = 1u << own;
    __syncthreads();
    if (lane == 0) atomicOr(s_blk, wmask);
    __syncthreads();
    blkmask = *s_blk;
  }
  const int nt = (MODE == 1) ? nt_none : ((a.q0 + 255) >> 6) + 1;
  auto advance = [&](int kt) {
    ++kt;
    if (MODE == 3) { while (kt < nt && !((blkmask >> (kt >> 2)) & 1u)) kt = (kt | 3) + 1; }
    return kt;
  };
  const int koff = pr * 128, kswz = (pr >> 1) & 7;
  const int kroff = 16384 + pr * 64, krswz = (pr >> 2) & 3;
  const int voff = 8192 + r * 128, vswz = (r >> 1) & 7;
  int kt = advance(-1);
  AtRegs g = at_issue<NKS2>(a, kt, tid);
  at_stage<NKS2>(smem, g, tid);
  int kt1 = advance(kt);
  if (kt1 < nt) g = at_issue<NKS2>(a, kt1, tid);
  uint2 mwn[2] = {make_uint2(0u, 0u), make_uint2(0u, 0u)};
  if (MODE == 2) {
    mwn[0] = *(const uint2*)(a.mask + (size_t)(q0w + r) * 128 + 2 * kt);
    mwn[1] = *(const uint2*)(a.mask + (size_t)(q0w + 32 + r) * 128 + 2 * kt);
  }
  __syncthreads();
  int buf = 0;
  while (kt < nt) {
    const int kt2 = (kt1 < nt) ? advance(kt1) : nt;
    const char* st = smem + buf * AT_STAGE;
    uint2 mw[2] = {mwn[0], mwn[1]};
    if (MODE == 2 && kt1 < nt) {
      mwn[0] = *(const uint2*)(a.mask + (size_t)(q0w + r) * 128 + 2 * kt1);
      mwn[1] = *(const uint2*)(a.mask + (size_t)(q0w + 32 + r) * 128 + 2 * kt1);
    }
#pragma unroll
    for (int qi = 0; qi < 2; ++qi) {
      const int qfirst = q0w + 32 * qi;
      if (MODE != 1 && 64 * kt > qfirst + 31) continue;
      if (MODE == 3 && (kt >> 2) < own && !((qmask[qi] >> (kt >> 2)) & 1u)) continue;
      bool lane_ok = true;
      if (MODE == 3) {
        const int jb = kt >> 2;
        if (jb < own) lane_ok = (selmask[qi] >> jb) & 1u;
      }
      f32x16 sacc[2];
#pragma unroll
      for (int ksub = 0; ksub < 2; ++ksub) {
        bf16x8 kf[NKS];
#pragma unroll
        for (int ks = 0; ks < 4; ++ks) kf[ks] = *(const bf16x8*)(st + ksub * 4096 + koff + (((ks * 2 + h) ^ kswz) << 4));
#pragma unroll
        for (int ks = 0; ks < NKS2; ++ks) kf[4 + ks] = *(const bf16x8*)(st + ksub * 2048 + kroff + (((ks * 2 + h) ^ krswz) << 4));
        f32x16 sa = zero16();
#pragma unroll
        for (int ks = 0; ks < NKS; ++ks) sa = MFMA32(kf[ks], qf[qi][ks], sa);
        sacc[ksub] = sa;
      }
      const bool diag = (MODE == 0 || MODE == 3) && (64 * kt + 63 > qfirst);
      float mloc = -INFINITY;
      if (MODE == 2 || diag || (MODE == 3 && (kt >> 2) < own)) {
#pragma unroll
        for (int ksub = 0; ksub < 2; ++ksub)
#pragma unroll
          for (int i = 0; i < 16; ++i) {
            bool ok = lane_ok;
            if (diag) ok = ok && (64 * kt + 32 * ksub + keyidx(i, h) <= qfirst + r);
            if (MODE == 2) ok = ((ksub ? mw[qi].y : mw[qi].x) >> keyidx(i, h)) & 1u;
            float sv = ok ? sacc[ksub][i] : -INFINITY;
            sacc[ksub][i] = sv;
            mloc = fmaxf(mloc, sv);
          }
      } else {
#pragma unroll
        for (int i = 0; i < 16; ++i) mloc = fmaxf(mloc, fmaxf(sacc[0][i], sacc[1][i]));
      }
      mloc = xh_max(mloc) * a.sc;
      const float mnew = fmaxf(m[qi], mloc);
      const float muse = (mnew == -INFINITY) ? 0.f : mnew;
      const float alpha = fexp2(m[qi] - muse);
      m[qi] = mnew;
      float psum = 0.f;
#pragma unroll
      for (int ksub = 0; ksub < 2; ++ksub)
#pragma unroll
        for (int i = 0; i < 16; ++i) { float pv = fexp2(fmaf(sacc[ksub][i], a.sc, -muse)); sacc[ksub][i] = pv; psum += pv; }
      l[qi] = l[qi] * alpha + psum;
      if (__ballot(alpha != 1.f) != 0ull) {
#pragma unroll
        for (int i = 0; i < 16; ++i) { o[qi][0][i] *= alpha; o[qi][1][i] *= alpha; }
      }
#pragma unroll
      for (int s4 = 0; s4 < 4; ++s4) {
        const bf16x8 pf = pack8(sacc[s4 >> 1], 8 * (s4 & 1));
        const bf16x8 v0 = *(const bf16x8*)(st + voff + (((s4 * 2 + h) ^ vswz) << 4));
        const bf16x8 v1 = *(const bf16x8*)(st + voff + 4096 + (((s4 * 2 + h) ^ vswz) << 4));
        o[qi][0] = MFMA32(v0, pf, o[qi][0]);
        o[qi][1] = MFMA32(v1, pf, o[qi][1]);
      }
      __builtin_amdgcn_sched_barrier(0);
    }
    if (kt1 < nt) at_stage<NKS2>(smem + (buf ^ 1) * AT_STAGE, g, tid);
    if (kt2 < nt) g = at_issue<NKS2>(a, kt2, tid);
    __syncthreads();
    kt = kt1; kt1 = kt2; buf ^= 1;
  }
  attn_store(p, o[0], 1.f / xh_sum(l[0]), rowbase + q0w + r, br, head, lane);
  attn_store(p, o[1], 1.f / xh_sum(l[1]), rowbase + q0w + 32 + r, br, head, lane);
}

DI void attn_blk_diff(const Params& p, int layer, int b, int head, int q0, int tid, char* smem) {
  const int lane = tid & 63, wave = tid >> 6, r = lane & 31, h = lane >> 5;
  const bf16* P = (const bf16*)(p.ws + OFF_P);
  AttnArgs a;
  a.Q = P + (size_t)b * SEQ * PW + P_CQ + head * 64; a.qs = PW;
  a.K1 = P + (size_t)b * SEQ * PW + P_CK + head * 64; a.k1s = PW;
  a.K2 = nullptr; a.k2s = 0;
  a.Vt = (const bf16*)(p.ws + OFF_VTC) + (size_t)(b * 4 + head) * 64 * SEQ; a.vts = SEQ;
  a.q0 = q0; a.sc = 0.17677669529663687f * LOG2E; a.mask = nullptr; a.kbar = nullptr;
  const int qfirst = q0 + wave * 32;
  bf16x8 qf[4];
#pragma unroll
  for (int ks = 0; ks < 4; ++ks) qf[ks] = ldg8(a.Q + (size_t)(qfirst + r) * PW + ks * 16 + 8 * h);
  f32x16 o1[2], o2[2];
  o1[0] = zero16(); o1[1] = zero16(); o2[0] = zero16(); o2[1] = zero16();
  float m1 = -INFINITY, l1 = 0.f, m2 = -INFINITY, l2 = 0.f;
  const float sc = a.sc;
  const int pr = pi_perm(r);
  const int koff = pr * 128, kswz = (pr >> 1) & 7;
  const int voff = 8192 + r * 128, vswz = (r >> 1) & 7;
  const int nt = ((q0 + 127) >> 6) + 1;
  AtRegs g = at_issue<0>(a, 0, tid);
  at_stage<0>(smem, g, tid);
  if (1 < nt) g = at_issue<0>(a, 1, tid);
  __syncthreads();
  int buf = 0;
  for (int kt = 0; kt < nt; ++kt) {
    const char* st = smem + buf * AT_STAGE;
    if (64 * kt <= qfirst + 31) {
      f32x16 s1[2], s2[2];
#pragma unroll
      for (int ksub = 0; ksub < 2; ++ksub) {
        bf16x8 kf[4];
#pragma unroll
        for (int ks = 0; ks < 4; ++ks) kf[ks] = *(const bf16x8*)(st + ksub * 4096 + koff + (((ks * 2 + h) ^ kswz) << 4));
        f32x16 x1 = zero16(), x2 = zero16();
        x1 = MFMA32(kf[0], qf[0], x1); x2 = MFMA32(kf[2], qf[2], x2);
        x1 = MFMA32(kf[1], qf[1], x1); x2 = MFMA32(kf[3], qf[3], x2);
        s1[ksub] = x1; s2[ksub] = x2;
      }
      const bool diag = (64 * kt + 63 > qfirst);
      float ml1 = -INFINITY, ml2 = -INFINITY;
      if (diag) {
#pragma unroll
        for (int ksub = 0; ksub < 2; ++ksub)
#pragma unroll
          for (int i = 0; i < 16; ++i) {
            bool ok = (64 * kt + 32 * ksub + keyidx(i, h) <= qfirst + r);
            float x = ok ? s1[ksub][i] : -INFINITY, y = ok ? s2[ksub][i] : -INFINITY;
            s1[ksub][i] = x; s2[ksub][i] = y;
            ml1 = fmaxf(ml1, x); ml2 = fmaxf(ml2, y);
          }
      } else {
#pragma unroll
        for (int i = 0; i < 16; ++i) {
          ml1 = fmaxf(ml1, fmaxf(s1[0][i], s1[1][i]));
          ml2 = fmaxf(ml2, fmaxf(s2[0][i], s2[1][i]));
        }
      }
      ml1 = xh_max(ml1) * sc; ml2 = xh_max(ml2) * sc;
      const float mn1 = fmaxf(m1, ml1), mn2 = fmaxf(m2, ml2);
      const float al1 = fexp2(m1 - mn1), al2 = fexp2(m2 - mn2);
      m1 = mn1; m2 = mn2;
      float ps1 = 0.f, ps2 = 0.f;
#pragma unroll
      for (int ksub = 0; ksub < 2; ++ksub)
#pragma unroll
        for (int i = 0; i < 16; ++i) {
          float x = fexp2(fmaf(s1[ksub][i], sc, -mn1)), y = fexp2(fmaf(s2[ksub][i], sc, -mn2));
          s1[ksub][i] = x; s2[ksub][i] = y; ps1 += x; ps2 += y;
        }
      l1 = l1 * al1 + ps1; l2 = l2 * al2 + ps2;
      if (__ballot((al1 != 1.f) || (al2 != 1.f)) != 0ull) {
#pragma unroll
        for (int i = 0; i < 16; ++i) { o1[0][i] *= al1; o1[1][i] *= al1; o2[0][i] *= al2; o2[1][i] *= al2; }
      }
#pragma unroll
      for (int s4 = 0; s4 < 4; ++s4) {
        const bf16x8 p1 = pack8(s1[s4 >> 1], 8 * (s4 & 1)), p2 = pack8(s2[s4 >> 1], 8 * (s4 & 1));
        const bf16x8 v0 = *(const bf16x8*)(st + voff + (((s4 * 2 + h) ^ vswz) << 4));
        const bf16x8 v1 = *(const bf16x8*)(st + voff + 4096 + (((s4 * 2 + h) ^ vswz) << 4));
        o1[0] = MFMA32(v0, p1, o1[0]); o1[1] = MFMA32(v1, p1, o1[1]);
        o2[0] = MFMA32(v0, p2, o2[0]); o2[1] = MFMA32(v1, p2, o2[1]);
      }
    }
    if (kt + 1 < nt) at_stage<0>(smem + (buf ^ 1) * AT_STAGE, g, tid);
    if (kt + 2 < nt) g = at_issue<0>(a, kt + 2, tid);
    __syncthreads();
    buf ^= 1;
  }
  l1 = xh_sum(l1); l2 = xh_sum(l2);
  const float* dl = p.diff_lam + (size_t)layer * 128;
  float d01 = dl[r] * dl[32 + r], d23 = dl[64 + r] * dl[96 + r];
#pragma unroll
  for (int off = 16; off >= 1; off >>= 1) { d01 += __shfl_xor(d01, off); d23 += __shfl_xor(d23, off); }
  const float lam_init = 0.8f - 0.6f * expf(-0.3f * (float)layer);
  const float lam = expf(d01) - expf(d23) + lam_init;
  const float i1 = 1.f / l1, i2 = lam / l2;
  float ss = 0.f;
#pragma unroll
  for (int dt = 0; dt < 2; ++dt)
#pragma unroll
    for (int i = 0; i < 16; ++i) { float v = o1[dt][i] * i1 - o2[dt][i] * i2; o1[dt][i] = v; ss += v * v; }
  ss = xh_sum(ss);
  const float rs = rsqrtf(ss * (1.f / 64.f) + 1e-6f) * (1.f - lam_init);
  const float* dn = p.diff_norm + (size_t)layer * 64;
#pragma unroll
  for (int dt = 0; dt < 2; ++dt)
#pragma unroll
    for (int i = 0; i < 16; ++i) o1[dt][i] *= dn[dt * 32 + crow(i, h)];
  attn_store(p, o1, rs, b * SEQ + qfirst + r, 2, head, lane);
}

DI void dsa_scores(const Params& p, int b, int qt, int kt0, int kt1, int lane) {
  const int r = lane & 31, h = lane >> 5;
  const bf16* P = (const bf16*)(p.ws + OFF_P) + (size_t)b * SEQ * PW;
  const float* IW = (const float*)(p.ws + OFF_IW) + (size_t)b * SEQ * 8;
  float* SC = (float*)(p.ws + OFF_SC) + (size_t)b * SC_PB + (size_t)1024 * ((size_t)qt * (qt + 1) / 2);
  const int q = qt * 32 + r;
  bf16x8 qf[8][2];
#pragma unroll
  for (int ih = 0; ih < 8; ++ih)
#pragma unroll
    for (int ks = 0; ks < 2; ++ks) qf[ih][ks] = ldg8(P + (size_t)q * PW + P_IQ + ih * 32 + ks * 16 + 8 * h);
  float w[8];
#pragma unroll
  for (int ih = 0; ih < 8; ++ih) w[ih] = IW[(size_t)q * 8 + ih] * 0.0625f;
  const int rowlen = (qt + 1) * 32;
  float* rowp = SC + (size_t)r * rowlen;
  for (int kt = kt0; kt < kt1; ++kt) {
    bf16x8 k0 = ldg8(P + (size_t)(kt * 32 + r) * PW + P_IK + 8 * h);
    bf16x8 k1 = ldg8(P + (size_t)(kt * 32 + r) * PW + P_IK + 16 + 8 * h);
    f32x16 sc = zero16();
#pragma unroll
    for (int ih = 0; ih < 8; ++ih) {
      f32x16 s = zero16();
      s = MFMA32(k0, qf[ih][0], s);
      s = MFMA32(k1, qf[ih][1], s);
#pragma unroll
      for (int i = 0; i < 16; ++i) sc[i] += fmaxf(s[i], 0.f) * w[ih];
      if (ih & 1) __builtin_amdgcn_sched_barrier(0);
    }
#pragma unroll
    for (int g = 0; g < 4; ++g) {
      float4 v = make_float4(sc[4 * g], sc[4 * g + 1], sc[4 * g + 2], sc[4 * g + 3]);
      *(float4*)(rowp + kt * 32 + 8 * g + 4 * h) = v;
    }
  }
}

DI const float* dsa_rowptr(const Params& p, int n, int& t, int& ngr) {
  const int b = n >> 12;
  t = n & (SEQ - 1);
  const int qt = t >> 5, r = t & 31;
  const int rowlen = (qt + 1) * 32;
  ngr = (((rowlen + 63) >> 6) + 7) >> 3;
  return (const float*)(p.ws + OFF_SC) + (size_t)b * SC_PB + (size_t)1024 * ((size_t)qt * (qt + 1) / 2) + (size_t)r * rowlen;
}
DI void dsa_select_wave(const Params& p, int nfirst, int nstride, int lane) {
  uint32_t u[64], f[64];
  int n = nfirst;
  if (n < 0) return;
  int t, ngr;
  {
    const float* rowp = dsa_rowptr(p, n, t, ngr);
#pragma unroll
    for (int g = 0; g < 8; ++g) {
      if (g < ngr) {
#pragma unroll
        for (int e = 0; e < 8; ++e) { int j = (g * 8 + e) * 64 + lane; f[g * 8 + e] = __float_as_uint(rowp[j <= t ? j : t]); }
      }
    }
  }
  while (n >= 0) {
#pragma unroll
    for (int g = 0; g < 8; ++g) {
#pragma unroll
      for (int e = 0; e < 8; ++e) {
        const int c = g * 8 + e, j = c * 64 + lane;
        uint32_t bits = f[c];
        uint32_t key = (bits & 0x80000000u) ? ~bits : (bits | 0x80000000u);
        u[c] = (g < ngr && j <= t) ? key : 0u;
      }
    }
    const int tc = t, ngc = ngr, nc = n;
    n -= nstride;
    if (n >= 0) {
      const float* rowp = dsa_rowptr(p, n, t, ngr);
#pragma unroll
      for (int g = 0; g < 8; ++g) {
        if (g < ngr) {
#pragma unroll
          for (int e = 0; e < 8; ++e) { int j = (g * 8 + e) * 64 + lane; f[g * 8 + e] = __float_as_uint(rowp[j <= t ? j : t]); }
        }
      }
    }
    uint32_t* mk = (uint32_t*)(p.ws + OFF_MASK) + (size_t)nc * 128;
    const int nch = (((tc >> 5) + 1) * 32 + 63) >> 6;
    uint32_t tau = 0u;
    int need_eq = 0;
    const bool all = (tc + 1 <= 256);
    bool exact = false;
    if (!all) {
      for (int bit = 31; bit >= 0; --bit) {
        const uint32_t cand = tau | (1u << bit);
        int cv = 0;
#pragma unroll
        for (int g = 0; g < 8; ++g) {
          if (g < ngc) {
#pragma unroll
            for (int e = 0; e < 8; ++e) cv += (int)(u[g * 8 + e] >= cand);
          }
        }
        int cnt = 0;
#pragma unroll
        for (int k = 0; k < 7; ++k) cnt += __popcll(__ballot((cv >> k) & 1)) << k;
        if (cnt >= 256) { tau = cand; if (cnt == 256) { exact = true; break; } }
      }
      if (!exact) {
        int cgt = 0;
#pragma unroll
        for (int g = 0; g < 8; ++g) {
          if (g < ngc) {
#pragma unroll
            for (int e = 0; e < 8; ++e) cgt += __popcll(__ballot(u[g * 8 + e] > tau));
          }
        }
        need_eq = 256 - cgt;
      }
    }
    int eq_seen = 0;
    const uint64_t lt_mask = (lane == 0) ? 0ull : (~0ull >> (64 - lane));
#pragma unroll
    for (int g = 0; g < 8; ++g) {
      if (g < ngc) {
#pragma unroll
        for (int e = 0; e < 8; ++e) {
          const int c = g * 8 + e;
          uint64_t selb;
          if (all) {
            selb = __ballot(u[c] != 0u);
          } else if (exact) {
            selb = __ballot(u[c] >= tau);
          } else {
            uint64_t gtb = __ballot(u[c] > tau);
            uint64_t eqb = __ballot(u[c] == tau);
            int myrank = eq_seen + __popcll(eqb & lt_mask);
            uint64_t eqsel = __ballot((u[c] == tau) && (myrank < need_eq));
            eq_seen += __popcll(eqb);
            selb = gtb | eqsel;
          }
          if (lane == 0 && c < nch) {
            mk[2 * c] = (uint32_t)selb;
            mk[2 * c + 1] = (uint32_t)(selb >> 32);
          }
        }
      }
    }
  }
}

#define XB_TMO      128
#define XB_XCNT(j)  (256  + 64 * (j))
#define XB_XSUB(j)  (1280 + 64 * (j))
#define XB_XGEN(j)  (2304 + 64 * (j))
#define XB_TOP      3328
#define XB_TOPGEN   3392
#define XCD_BAR_WORDS 3456
#define XB_SPIN_CAP (1u << 18)
#define LAS __attribute__((address_space(3)))

__device__ __forceinline__ unsigned xb_ld(unsigned* p)              { return __hip_atomic_load(p, __ATOMIC_RELAXED, __HIP_MEMORY_SCOPE_AGENT); }
__device__ __forceinline__ unsigned xb_add(unsigned* p, unsigned v) { return __hip_atomic_fetch_add(p, v, __ATOMIC_RELAXED, __HIP_MEMORY_SCOPE_AGENT); }
__device__ __forceinline__ unsigned xb_xcc_id() { return (unsigned)__builtin_amdgcn_s_getreg((3 << 11) | 20) & 0xFu; }
#define XB_SPIN(cond, bar) do { unsigned _sp = 0; while (cond) { __builtin_amdgcn_s_sleep(1); \
    if ((++_sp & 255u) == 0u) { if (xb_ld(&(bar)[XB_TMO])) break; if (_sp > XB_SPIN_CAP) { atomicAdd(&(bar)[XB_TMO], 1u); break; } } } } while (0)

struct XcdBarrier {
    unsigned* bar; unsigned x;
    volatile LAS unsigned* st;
};

__device__ __forceinline__ XcdBarrier xcd_barrier_post(unsigned* bar, volatile LAS unsigned* st) {
    XcdBarrier b; b.bar = bar; b.x = xb_xcc_id(); b.st = st;
    if (threadIdx.x == 0) (void)xb_add(&bar[XB_XCNT(b.x)], 1u);
    return b;
}
__device__ __forceinline__ void xcd_barrier_complete(unsigned* bar, unsigned x, unsigned& nloc, unsigned& nx) {
    const unsigned G = gridDim.x * gridDim.y * gridDim.z;
    unsigned sum, cnt, mine, sp = 0u;
    for (;;) {
        sum = 0u; cnt = 0u; mine = 0u;
#pragma unroll
        for (unsigned j = 0; j < 16; ++j) { const unsigned c = xb_ld(&bar[XB_XCNT(j)]); sum += c; cnt += (c > 0u) ? 1u : 0u; mine = (j == x) ? c : mine; }
        if (sum == G) break;
        __builtin_amdgcn_s_sleep(1);
        if ((++sp & 255u) == 0u) { if (xb_ld(&bar[XB_TMO])) break; if (sp > XB_SPIN_CAP) { atomicAdd(&bar[XB_TMO], 1u); break; } }
    }
    nloc = mine > 0u ? mine : 1u; nx = cnt > 0u ? cnt : 1u;
}

__device__ __forceinline__ void xcd_barrier(const XcdBarrier& b) {
    asm volatile("s_waitcnt vmcnt(0)" ::: "memory");
    __syncthreads();
    if (threadIdx.x == 0) {
        unsigned* bar = b.bar;
        __builtin_amdgcn_s_waitcnt(0);
        unsigned nloc = b.st[0], nx = b.st[1];
        if (nloc == 0u) { xcd_barrier_complete(bar, b.x, nloc, nx); b.st[0] = nloc; b.st[1] = nx; }
        const unsigned old = xb_add(&bar[XB_XSUB(b.x)], 1u);
        const unsigned gen = old / nloc;
        if (old + 1u == (gen + 1u) * nloc) {
            __builtin_amdgcn_fence(__ATOMIC_RELEASE, "agent");
            asm volatile("s_waitcnt vmcnt(0)" ::: "memory");
            const unsigned og = xb_add(&bar[XB_TOP], 1u);
            const unsigned tg = og / nx;
            if (og + 1u == (tg + 1u) * nx) xb_add(&bar[XB_TOPGEN], 1u);
            else XB_SPIN(xb_ld(&bar[XB_TOPGEN]) == tg, bar);
            __builtin_amdgcn_fence(__ATOMIC_ACQUIRE, "agent");
            xb_add(&bar[XB_XGEN(b.x)], 1u);
            asm volatile("s_waitcnt vmcnt(0)" ::: "memory");
        } else {
            XB_SPIN(xb_ld(&bar[XB_XGEN(b.x)]) == gen, bar);
            __builtin_amdgcn_fence(__ATOMIC_ACQUIRE, "agent");
            asm volatile("s_waitcnt vmcnt(0)" ::: "memory");
        }
    }
    __syncthreads();
}


#define LAUNDER()                                                                                      \
  int tid;                                                                                             \
  asm volatile("v_mbcnt_lo_u32_b32 %0, -1, 0\n\tv_mbcnt_hi_u32_b32 %0, -1, %0" : "=v"(tid));              \
  tid |= wave_s << 6;                                                                                  \
  asm volatile("" : "+v"(tid));                                                                        \
  Params p = p0;                                                                                       \
  size_t zoff = 0;                         \
  asm volatile("" : "+s"(zoff));           \
  p.ws = p0.ws + zoff;                                                                                 \
  p.out = p0.out + zoff;                                                                               \
  const int lane = tid & 63, wave = tid >> 6;                                                          \
  char* ws = p.ws;                                                                                     \
  bf16* HB = (bf16*)(ws + OFF_HB);                                                                     \
  bf16* WINT = (bf16*)(ws + OFF_WINT);                                                                 \
  bf16* P = (bf16*)(ws + OFF_P);                                                                       \
  float* rope = (float*)(ws + OFF_ROPE);                                                               \
  (void)lane; (void)wave; (void)HB; (void)WINT; (void)P; (void)rope;

__global__ void __launch_bounds__(256, 2) mega(Params p0) {
  __shared__ __attribute__((aligned(16))) char smem[65536];
  __shared__ float s_rs[128];
  __shared__ uint4 xb_words;
  __shared__ int s_item;
  __shared__ unsigned s_blk;
  cg::grid_group grid = cg::this_grid();
  const int wave_s = __builtin_amdgcn_readfirstlane((int)(threadIdx.x >> 6));
  if (threadIdx.x == 0) xb_words = make_uint4(0u, 0u, 0u, 0u);
  __syncthreads();
  (void)xcd_barrier_post((unsigned*)(p0.ws + OFF_BAR), (volatile LAS unsigned*)&xb_words);
#define XBAR() do { XcdBarrier xb_; xb_.bar = (unsigned*)(p0.ws + OFF_BAR); xb_.x = xb_xcc_id(); xb_.st = (volatile LAS unsigned*)&xb_words; xcd_barrier(xb_); xcd_barrier(xb_); } while (0)

  grid.sync();

  {
  LAUNDER();
  const int gtid = blockIdx.x * 256 + tid, gthreads = gridDim.x * 256;
  ln_rows(p.x, p.ln0_g, p.ln0_b, p.out, HB, tid);
  for (int i = gtid; i < SEQ * 28; i += gthreads) {
    int t = i / 28, f = i % 28;
    int rot, fi, co, so;
    if (f < 8) { rot = 16; fi = f; co = R_CS64 + t * 8 + fi; so = R_SN64 + t * 8 + fi; }
    else if (f < 12) { rot = 8; fi = f - 8; co = R_CS32 + t * 4 + fi; so = R_SN32 + t * 4 + fi; }
    else { rot = 32; fi = f - 12; co = R_CSM + t * 16 + fi; so = R_SNM + t * 16 + fi; }
    float inv = (float)pow(500000.0, -(double)(2 * fi) / (double)rot);
    float ang = (float)t * inv;
    rope[co] = (float)cos((double)ang);
    rope[so] = (float)sin((double)ang);
  }
  {
    bf16* MEMB = (bf16*)(ws + OFF_MEMB);
    for (int i = gtid; i < NB * NMEM * DM / 2; i += gthreads) {
      float2 v = ((const float2*)p.mem)[i];
      ((uint32_t*)MEMB)[i] = pack2(v.x, v.y);
    }
  }
  for (int t = blockIdx.x; t < 2432 + DEPTH * 744; t += gridDim.x) {
    if (t < 2432) {
      conv_tile<true>(p.w_in, 1024, INW, WINT, nullptr, smem, tid, t);
    } else {
      const int u = t - 2432, l = u / 744;
      int v = u % 744;
      if (v < 320) {
        const int n = v >> 6;
        conv_tile<false>(p.w_branch + ((size_t)l * 5 + n) * 256 * 1024, 256, 1024,
                         (bf16*)(ws + OFF_WBT) + ((size_t)l * 5 + n) * 1024 * 256, nullptr, smem, tid, v & 63);
      } else if ((v -= 320) < 256) {
        conv_tile<false>(p.w_out + (size_t)l * 1024 * 1024, 1024, 1024, (bf16*)(ws + OFF_WOT) + (size_t)l * 1024 * 1024, nullptr, smem, tid, v);
      } else if ((v -= 256) < 24) {
        conv_tile<false>(p.w_uq + (size_t)l * 256 * 384, 256, 384, (bf16*)(ws + OFF_WUQT) + (size_t)l * 384 * 256, p.mla_q_norm + l * 256, smem, tid, v);
      } else if ((v -= 24) < 16) {
        conv_tile<false>(p.w_ukv + (size_t)l * 128 * 512, 128, 512, (bf16*)(ws + OFF_WUKVT) + (size_t)l * 512 * 128, p.mla_kv_norm + l * 128, smem, tid, v);
      } else {
        v -= 16;
        conv_tile<false>(p.w_mem_kv + (size_t)l * 1024 * 512, 1024, 512, (bf16*)(ws + OFF_WMKVT) + (size_t)l * 512 * 1024, nullptr, smem, tid, v);
      }
    }
  }
  }
  XBAR();

  for (int layer = 0; layer < DEPTH; ++layer) {
    {
      LAUNDER();
      const int nt_in = 128 * 76;
      const int nt_tot = nt_in + (layer == 0 ? DEPTH * 32 : 0);
      auto tile_ptrs = [&](int it, const bf16*& Ap, const bf16*& Bp) {
        if (it < nt_in) {
          Ap = HB + (size_t)(it & 127) * 128 * 1024;
          Bp = WINT + (size_t)(it >> 7) * 128 * 1024;
        } else {
          const int j = it - nt_in, l = j >> 5, mt = (j & 31) >> 2, nt = j & 3;
          Ap = (const bf16*)(ws + OFF_MEMB) + (size_t)mt * 128 * 1024;
          Bp = (const bf16*)(ws + OFF_WMKVT) + ((size_t)l * 512 + nt * 128) * 1024;
        }
      };
      GStage g;
      {
        const bf16 *Ap, *Bp;
        tile_ptrs(blockIdx.x, Ap, Bp);
        g = gemm_issue(Ap, 1024, Bp, 1024, 0, tid);
      }
      for (int it = blockIdx.x; it < nt_tot; it += gridDim.x) {
        f32x16 acc[2][2];
        acc[0][0] = zero16(); acc[0][1] = zero16(); acc[1][0] = zero16(); acc[1][1] = zero16();
        const bf16 *Ap, *Bp;
        tile_ptrs(it, Ap, Bp);
        int t2 = tid;
        gemm_core_u<16>(Ap, 1024, Bp, 1024, acc, smem, t2, g);
        if (it + (int)gridDim.x < nt_tot) {
          const bf16 *An, *Bn;
          tile_ptrs(it + gridDim.x, An, Bn);
          g = gemm_issue(An, 1024, Bn, 1024, 0, t2);
        }
        if (it < nt_in) {
          int mt = it & 127, ct = it >> 7;
          epi_inproj(p, acc, mt, ct, t2, smem);
        } else {
          int j = it - nt_in, l = j >> 5, mt = (j & 31) >> 2, nt = j & 3;
          const int wm = t2 >> 7, wn = (t2 >> 6) & 1, r = t2 & 31, h = (t2 >> 5) & 1;
#pragma unroll
          for (int mi = 0; mi < 2; ++mi)
#pragma unroll
            for (int ni = 0; ni < 2; ++ni) {
              asm volatile("" ::: "memory");
              int rowb = mt * 128 + wm * 64 + mi * 32;
              int col = nt * 128 + wn * 64 + ni * 32 + r;
              if (nt < 2) {
                store_rm((bf16*)(ws + OFF_MK) + (size_t)l * 1024 * 256, 256, rowb, col, acc[mi][ni], h);
              } else {
                int bb = rowb >> 8, c2 = col - 256;
                bf16* vt = (bf16*)(ws + OFF_VTM) + ((size_t)(l * 4 + bb) * 4 + (c2 >> 6)) * 64 * 256;
                store_vt(vt, 256, c2 & 63, rowb & 255, acc[mi][ni], h);
              }
            }
        }
      }
    }
    XBAR();

    {
      LAUNDER();
      for (int wi = blockIdx.x * 4 + wave; wi < 4 * 1088; wi += gridDim.x * 4) {
        const int b = wi & 3;
        int idx = 1087 - (wi >> 2);
        int jg = 0;
        while (4 * (jg + 1) * (jg + 2) <= idx) ++jg;
        const int rem = idx - 4 * jg * (jg + 1);
        const int qt = 8 * jg + rem / (jg + 1), c = rem % (jg + 1);
        const int kt1 = (8 * c + 8 < qt + 1) ? 8 * c + 8 : qt + 1;
        dsa_scores(p, b, qt, 8 * c, kt1, lane);
      }
    }
    {
      LAUNDER();
      for (int it = blockIdx.x; it < 128 * 3; it += gridDim.x) {
          constexpr bool isq = true;
          int j = it;
          int mt = isq ? j / 3 : j >> 2, nt = isq ? j % 3 : j & 3;
          constexpr int KK = isq ? 256 : 128;
          const bf16* A = P + (size_t)mt * 128 * PW + (isq ? P_DCQ : P_DCKV);
          {
            int row = tid >> 1, half = tid & 1;
            const bf16* ap = A + (size_t)row * PW + half * (KK / 2);
            float ss = 0.f;
            for (int c = 0; c < KK / 16; ++c) {
              bf16x8 v = ldg8(ap + c * 8);
#pragma unroll
              for (int e = 0; e < 8; ++e) { float f = bf2f((bf16)v[e]); ss += f * f; }
            }
            ss += __shfl_xor(ss, 1);
            if (half == 0) s_rs[row] = rsqrtf(ss / (float)KK + 1e-6f);
          }
          f32x16 acc[2][2];
          acc[0][0] = zero16(); acc[0][1] = zero16(); acc[1][0] = zero16(); acc[1][1] = zero16();
          const bf16* Bt = isq ? (const bf16*)(ws + OFF_WUQT) + ((size_t)layer * 384 + nt * 128) * 256
                               : (const bf16*)(ws + OFF_WUKVT) + ((size_t)layer * 512 + nt * 128) * 128;
          int t2 = tid;
          gemm_full<KK / 64>(A, PW, Bt, KK, acc, smem, t2);
          const int wm = t2 >> 7, wn = (t2 >> 6) & 1, r = t2 & 31, h = (t2 >> 5) & 1;
#pragma unroll
          for (int mi = 0; mi < 2; ++mi)
#pragma unroll
            for (int ni = 0; ni < 2; ++ni) {
              asm volatile("" ::: "memory");
              f32x16 v = acc[mi][ni];
              int rl = wm * 64 + mi * 32;
              int rowb = mt * 128 + rl;
#pragma unroll
              for (int i = 0; i < 16; ++i) v[i] *= s_rs[rl + crow(i, h)];
              if (isq) {
                int ctile = nt * 4 + wn * 2 + ni;
                if (ctile % 3 == 2) rope_tile<16>(v, r, h, rowb, rope + R_CSM, rope + R_SNM);
                store_rm((bf16*)(ws + OFF_QF), 384, rowb, ctile * 32 + r, v, h);
              } else {
                if (wn == 0) {
                  store_rm((bf16*)(ws + OFF_KN), 256, rowb, nt * 64 + ni * 32 + r, v, h);
                } else {
                  int bb = rowb >> 12;
                  bf16* vt = (bf16*)(ws + OFF_VTD) + (size_t)(bb * 4 + nt) * 64 * SEQ;
                  store_vt(vt, SEQ, ni * 32 + r, rowb & (SEQ - 1), v, h);
                }
              }
            }
          __syncthreads();
      }
    }
    {
      LAUNDER();
      for (int it = blockIdx.x; it < 128 * 4; it += gridDim.x) {
          constexpr bool isq = false;
          int j = it;
          int mt = isq ? j / 3 : j >> 2, nt = isq ? j % 3 : j & 3;
          constexpr int KK = isq ? 256 : 128;
          const bf16* A = P + (size_t)mt * 128 * PW + (isq ? P_DCQ : P_DCKV);
          {
            int row = tid >> 1, half = tid & 1;
            const bf16* ap = A + (size_t)row * PW + half * (KK / 2);
            float ss = 0.f;
            for (int c = 0; c < KK / 16; ++c) {
              bf16x8 v = ldg8(ap + c * 8);
#pragma unroll
              for (int e = 0; e < 8; ++e) { float f = bf2f((bf16)v[e]); ss += f * f; }
            }
            ss += __shfl_xor(ss, 1);
            if (half == 0) s_rs[row] = rsqrtf(ss / (float)KK + 1e-6f);
          }
          f32x16 acc[2][2];
          acc[0][0] = zero16(); acc[0][1] = zero16(); acc[1][0] = zero16(); acc[1][1] = zero16();
          const bf16* Bt = isq ? (const bf16*)(ws + OFF_WUQT) + ((size_t)layer * 384 + nt * 128) * 256
                               : (const bf16*)(ws + OFF_WUKVT) + ((size_t)layer * 512 + nt * 128) * 128;
          int t2 = tid;
          gemm_full<KK / 64>(A, PW, Bt, KK, acc, smem, t2);
          const int wm = t2 >> 7, wn = (t2 >> 6) & 1, r = t2 & 31, h = (t2 >> 5) & 1;
#pragma unroll
          for (int mi = 0; mi < 2; ++mi)
#pragma unroll
            for (int ni = 0; ni < 2; ++ni) {
              asm volatile("" ::: "memory");
              f32x16 v = acc[mi][ni];
              int rl = wm * 64 + mi * 32;
              int rowb = mt * 128 + rl;
#pragma unroll
              for (int i = 0; i < 16; ++i) v[i] *= s_rs[rl + crow(i, h)];
              if (isq) {
                int ctile = nt * 4 + wn * 2 + ni;
                if (ctile % 3 == 2) rope_tile<16>(v, r, h, rowb, rope + R_CSM, rope + R_SNM);
                store_rm((bf16*)(ws + OFF_QF), 384, rowb, ctile * 32 + r, v, h);
              } else {
                if (wn == 0) {
                  store_rm((bf16*)(ws + OFF_KN), 256, rowb, nt * 64 + ni * 32 + r, v, h);
                } else {
                  int bb = rowb >> 12;
                  bf16* vt = (bf16*)(ws + OFF_VTD) + (size_t)(bb * 4 + nt) * 64 * SEQ;
                  store_vt(vt, SEQ, ni * 32 + r, rowb & (SEQ - 1), v, h);
                }
              }
            }
          __syncthreads();
      }
    }
    {
      LAUNDER();
      for (int it = (int)gridDim.x - 1 - (int)blockIdx.x; it < 64; it += gridDim.x) {
        const int bb = it >> 4, blk = it & 15;
        const int cg = tid & 31, rsub = tid >> 5;
        const bf16* kp = P + ((size_t)bb * SEQ + blk * 256 + rsub) * PW + P_BK + cg * 8;
        float a8[8];
#pragma unroll
        for (int e = 0; e < 8; ++e) a8[e] = 0.f;
#pragma unroll 8
        for (int k = 0; k < 32; ++k) {
          const uint4 v = *(const uint4*)(kp + (size_t)k * 8 * PW);
          const uint32_t w[4] = {v.x, v.y, v.z, v.w};
#pragma unroll
          for (int e = 0; e < 4; ++e) { a8[2 * e] += bf2f((bf16)(w[e] & 0xffffu)); a8[2 * e + 1] += bf2f((bf16)(w[e] >> 16)); }
        }
        float* red = (float*)smem;
#pragma unroll
        for (int e = 0; e < 8; ++e) red[rsub * 256 + cg * 8 + e] = a8[e];
        __syncthreads();
        float sacc = 0.f;
#pragma unroll
        for (int q = 0; q < 8; ++q) sacc += red[q * 256 + tid];
        ((bf16*)(ws + OFF_KBAR))[((size_t)(bb * 4 + (tid >> 6)) * 32 + blk) * 64 + (tid & 63)] = f2bf(sacc * (1.f / 256.f));
        __syncthreads();
      }
    }
    XBAR();

    {
      LAUNDER();
      dsa_select_wave(p, NTOK - 1 - (int)(blockIdx.x * 4 + wave), (int)gridDim.x * 4, lane);
    }
    XBAR();

    {
    LAUNDER();
    unsigned* qctr = (unsigned*)(ws + OFF_BAR) + XCD_BAR_WORDS + layer * 16;
    for (int dx = 0; dx < 8; ++dx) {
      const int xq = ((int)xb_xcc_id() + dx) & 7;
      for (;;) {
        if (tid == 0) s_item = (int)atomicAdd(&qctr[xq], 1u);
        __syncthreads();
        const int kq = s_item;
        __syncthreads();
        if (kq >= 192) break;
        int tid_i = tid;
        asm volatile("" : "+v"(tid_i));
      int br, qt, sub;
      if (kq < 64) { br = 2; qt = 31 - (kq >> 1); sub = kq & 1; }
      else {
        const int k2 = kq - 64, gp = k2 >> 5, rem = k2 & 31;
        br = gp == 0 ? 3 : (gp == 1 ? 0 : (gp == 2 ? 1 : 4));
        qt = 15 - (rem >> 1); sub = rem & 1;
      }
      const int bh = xq + 8 * sub;
      const int b = bh >> 2, head = bh & 3;
      if (br == 2) {
        attn_blk_diff(p, layer, b, head, qt * 128, tid_i, smem);
      } else {
        const int q0 = qt * 256;
        AttnArgs a;
        a.q0 = q0; a.mask = nullptr; a.kbar = nullptr; a.K2 = nullptr; a.k2s = 0;
        const bf16* Pb = P + (size_t)b * SEQ * PW;
        if (br == 0) {
          a.Q = Pb + P_AQ + head * 64; a.qs = PW; a.K1 = Pb + P_AK + head * 64; a.k1s = PW;
          a.Vt = (const bf16*)(ws + OFF_VTA) + (size_t)(b * 4 + head) * 64 * SEQ; a.vts = SEQ;
          a.sc = 0.125f * LOG2E; a.mask = (const uint32_t*)(ws + OFF_MASK) + (size_t)b * SEQ * 128;
          attn_blk_std<2, 0>(p, a, 0, tid_i, br, head, b * SEQ, smem, &s_blk);
        } else if (br == 1) {
          a.Q = Pb + P_BQ + head * 64; a.qs = PW; a.K1 = Pb + P_BK + head * 64; a.k1s = PW;
          a.Vt = (const bf16*)(ws + OFF_VTB) + (size_t)(b * 4 + head) * 64 * SEQ; a.vts = SEQ;
          a.sc = 0.125f * LOG2E; a.kbar = (const bf16*)(ws + OFF_KBAR) + (size_t)(b * 4 + head) * 32 * 64;
          attn_blk_std<3, 0>(p, a, 0, tid_i, br, head, b * SEQ, smem, &s_blk);
        } else if (br == 3) {
          a.Q = (const bf16*)(ws + OFF_QF) + (size_t)b * SEQ * 384 + head * 96; a.qs = 384;
          a.K1 = (const bf16*)(ws + OFF_KN) + (size_t)b * SEQ * 256 + head * 64; a.k1s = 256;
          a.K2 = Pb + P_KR; a.k2s = PW;
          a.Vt = (const bf16*)(ws + OFF_VTD) + (size_t)(b * 4 + head) * 64 * SEQ; a.vts = SEQ;
          a.sc = 0.10206207261596575f * LOG2E;
          attn_blk_std<0, 2>(p, a, 0, tid_i, br, head, b * SEQ, smem, &s_blk);
        } else {
          a.Q = Pb + P_EQ + head * 64; a.qs = PW;
          a.K1 = (const bf16*)(ws + OFF_MK) + ((size_t)layer * 1024 + b * 256) * 256 + head * 64; a.k1s = 256;
          a.Vt = (const bf16*)(ws + OFF_VTM) + ((size_t)(layer * 4 + b) * 4 + head) * 64 * 256; a.vts = 256;
          a.sc = 0.125f * LOG2E;
          attn_blk_std<1, 0>(p, a, 4, tid_i, br, head, b * SEQ, smem, &s_blk);
        }
      }
      }
    }
    }
    XBAR();

    {
    LAUNDER();
    for (int it = blockIdx.x; it < 1024; it += gridDim.x) {
      const int mt = it & 127, nt = it >> 7;
      float sum[8][8];
#pragma unroll
      for (int ps = 0; ps < 8; ++ps)
#pragma unroll
        for (int e = 0; e < 8; ++e) sum[ps][e] = 0.f;
      for (int n = 0; n < 5; ++n) {
        int t2 = tid;
        uint4 gq[8];
        {
          const bf16* gp = P + (size_t)(mt * 128 + (t2 >> 4)) * PW + P_G + n * 1024 + nt * 128 + (t2 & 15) * 8;
#pragma unroll
          for (int ps = 0; ps < 4; ++ps) gq[ps] = *(const uint4*)(gp + (size_t)ps * 16 * PW);
        }
        f32x16 acc[2][2];
        acc[0][0] = zero16(); acc[0][1] = zero16(); acc[1][0] = zero16(); acc[1][1] = zero16();
        gemm_full_loop((const bf16*)(ws + OFF_Y) + (size_t)mt * 128 * 1280 + n * 256, 1280,
                  (const bf16*)(ws + OFF_WBT) + (((size_t)layer * 5 + n) * 1024 + nt * 128) * 256, 256, 256, acc, smem, t2);
        {
          const bf16* gp = P + (size_t)(mt * 128 + (t2 >> 4)) * PW + P_G + n * 1024 + nt * 128 + (t2 & 15) * 8;
#pragma unroll
          for (int ps = 4; ps < 8; ++ps) gq[ps] = *(const uint4*)(gp + (size_t)ps * 16 * PW);
        }
        float* C = (float*)smem;
        {
          const int wm = t2 >> 7, wn = (t2 >> 6) & 1, r = t2 & 31, h = (t2 >> 5) & 1;
#pragma unroll
          for (int mi = 0; mi < 2; ++mi)
#pragma unroll
            for (int ni = 0; ni < 2; ++ni)
#pragma unroll
              for (int i = 0; i < 16; ++i)
                C[(wm * 64 + mi * 32 + crow(i, h)) * 128 + wn * 64 + ni * 32 + r] = acc[mi][ni][i];
        }
        __syncthreads();
#pragma unroll
        for (int ps = 0; ps < 8; ++ps) {
          float x[8];
          ld8(C + (ps * 16 + (t2 >> 4)) * 128 + (t2 & 15) * 8, x);
          const uint32_t gw[4] = {gq[ps].x, gq[ps].y, gq[ps].z, gq[ps].w};
#pragma unroll
          for (int e = 0; e < 4; ++e) {
            sum[ps][2 * e] += bf2f((bf16)(gw[e] & 0xffffu)) * x[2 * e];
            sum[ps][2 * e + 1] += bf2f((bf16)(gw[e] >> 16)) * x[2 * e + 1];
          }
        }
        __syncthreads();
      }
#pragma unroll
      for (int ps = 0; ps < 8; ++ps)
        st8((bf16*)(ws + OFF_MERGED) + (size_t)(mt * 128 + ps * 16 + (tid >> 4)) * 1024 + nt * 128 + (tid & 15) * 8, sum[ps]);
    }
    }
    XBAR();

    {
    LAUNDER();
    for (int it = blockIdx.x; it < 1024; it += gridDim.x) {
      const int mt = it & 127, nt = it >> 7;
      f32x16 acc[2][2];
      acc[0][0] = zero16(); acc[0][1] = zero16(); acc[1][0] = zero16(); acc[1][1] = zero16();
      int t2 = tid;
      float* op = p.out + (size_t)(mt * 128 + (t2 >> 4)) * DM + nt * 128 + (t2 & 15) * 8;
      gemm_full<16>((const bf16*)(ws + OFF_MERGED) + (size_t)mt * 128 * 1024, 1024,
                (const bf16*)(ws + OFF_WOT) + ((size_t)layer * 1024 + nt * 128) * 1024, 1024, acc, smem, t2);
      float* C = (float*)smem;
      {
        const int wm = t2 >> 7, wn = (t2 >> 6) & 1, r = t2 & 31, h = (t2 >> 5) & 1;
#pragma unroll
        for (int mi = 0; mi < 2; ++mi)
#pragma unroll
          for (int ni = 0; ni < 2; ++ni)
#pragma unroll
            for (int i = 0; i < 16; ++i)
              C[(wm * 64 + mi * 32 + crow(i, h)) * 128 + wn * 64 + ni * 32 + r] = acc[mi][ni][i];
      }
      op = p.out + (size_t)(mt * 128 + (t2 >> 4)) * DM + nt * 128 + (t2 & 15) * 8;
      float4 ra[8], rb[8];
#pragma unroll
      for (int ps = 0; ps < 8; ++ps) { ra[ps] = *(const float4*)(op + (size_t)ps * 16 * DM); rb[ps] = *(const float4*)(op + (size_t)ps * 16 * DM + 4); }
      __syncthreads();
#pragma unroll
      for (int ps = 0; ps < 8; ++ps) {
        float x[8];
        ld8(C + (ps * 16 + (t2 >> 4)) * 128 + (t2 & 15) * 8, x);
        float4 o0, o1;
        o0.x = DN_ALPHA * ra[ps].x + x[0]; o0.y = DN_ALPHA * ra[ps].y + x[1]; o0.z = DN_ALPHA * ra[ps].z + x[2]; o0.w = DN_ALPHA * ra[ps].w + x[3];
        o1.x = DN_ALPHA * rb[ps].x + x[4]; o1.y = DN_ALPHA * rb[ps].y + x[5]; o1.z = DN_ALPHA * rb[ps].z + x[6]; o1.w = DN_ALPHA * rb[ps].w + x[7];
        *(float4*)(op + (size_t)ps * 16 * DM) = o0;
        *(float4*)(op + (size_t)ps * 16 * DM + 4) = o1;
      }
      __syncthreads();
    }
    }
    XBAR();

    {
    LAUNDER();
    ln_rows(p.out, p.ln_g + layer * DM, p.ln_b + layer * DM, p.out, (layer + 1 < DEPTH) ? HB : (bf16*)nullptr, tid);
    if (layer + 1 < DEPTH) {
      conv_matrix<true>(p.w_in + (size_t)(layer + 1) * 1024 * INW, 1024, INW, WINT, nullptr, smem, tid);
    }
    }
    if (layer + 1 < DEPTH) XBAR();
  }
}

extern "C" void kernel_launch(void* const* d_in, const int* in_sizes, int n_in, void* d_out, int out_size, void* d_ws,
                              size_t ws_size, hipStream_t stream) {
  static int grid_blocks = 0;
  if (!grid_blocks) {
    int dev = 0, cus = 0, per_cu = 0;
    hipGetDevice(&dev);
    hipDeviceGetAttribute(&cus, hipDeviceAttributeMultiprocessorCount, dev);
    hipOccupancyMaxActiveBlocksPerMultiprocessor(&per_cu, mega, 256, 0);
    if (per_cu > 2) per_cu = 2;
    grid_blocks = cus * per_cu;
  }
  if (ws_size < WS_TOTAL) { fprintf(stderr, "workspace too small: %zu < %zu\n", ws_size, (size_t)WS_TOTAL); return; }
  Params p{};
  p.x = (const float*)d_in[0]; p.mem = (const float*)d_in[1]; p.ln0_g = (const float*)d_in[2]; p.ln0_b = (const float*)d_in[3];
  p.w_in = (const float*)d_in[4]; p.mla_q_norm = (const float*)d_in[5]; p.w_uq = (const float*)d_in[6];
  p.mla_kv_norm = (const float*)d_in[7]; p.w_ukv = (const float*)d_in[8]; p.diff_lam = (const float*)d_in[9];
  p.diff_norm = (const float*)d_in[10]; p.w_mem_kv = (const float*)d_in[11]; p.w_branch = (const float*)d_in[12];
  p.w_out = (const float*)d_in[13]; p.ln_g = (const float*)d_in[14]; p.ln_b = (const float*)d_in[15];
  p.out = (float*)d_out; p.ws = (char*)d_ws;
  hipMemsetAsync((char*)d_ws + OFF_BAR, 0, 16384, stream);
  void* args[] = {&p};
  hipError_t e = hipLaunchCooperativeKernel((void*)mega, dim3(grid_blocks), dim3(256), args, 0, stream);
  if (e != hipSuccess) fprintf(stderr, "cooperative launch failed: %s (grid %d)\n", hipGetErrorString(e), grid_blocks);
}
```

```cpp
#include <hip/hip_runtime.h>
#include <hip/hip_cooperative_groups.h>
#include <stdint.h>
#include <cstdio>
namespace cg = cooperative_groups;

typedef uint16_t bf16;
typedef __attribute__((ext_vector_type(8))) short bf16x8;
typedef __attribute__((ext_vector_type(16))) float f32x16;

#define DI __device__ __forceinline__
#define MFMA32(a, b, c) __builtin_amdgcn_mfma_f32_32x32x16_bf16((a), (b), (c), 0, 0, 0)

constexpr int NTOK = 16384, SEQ = 4096, NB = 4, DM = 1024, DEPTH = 4, NMEM = 256;
constexpr int INW = 9672, WROWS = 9728, PW = 8960;
constexpr int P_AQ = 0, P_AK = 256, P_IQ = 512, P_BQ = 768, P_BK = 1024, P_CQ = 1280, P_CK = 1536, P_DCQ = 1792,
              P_EQ = 2048, P_Z = 2304, P_G = 3584, P_DCKV = 8704, P_IK = 8832, P_KR = 8864;
constexpr float LOG2E = 1.4426950408889634f;
constexpr float DN_ALPHA = 1.681792830507429f;
constexpr size_t SC_PB = 1024ull * 8256ull;

constexpr size_t OFF_HB = 0;
constexpr size_t OFF_WINT = OFF_HB + (size_t)NTOK * 1024 * 2;
constexpr size_t OFF_WBT = OFF_WINT + (size_t)WROWS * 1024 * 2;
constexpr size_t OFF_WOT = OFF_WBT + (size_t)DEPTH * 5 * 1024 * 256 * 2;
constexpr size_t OFF_WUQT = OFF_WOT + (size_t)DEPTH * 1024 * 1024 * 2;
constexpr size_t OFF_WUKVT = OFF_WUQT + (size_t)DEPTH * 384 * 256 * 2;
constexpr size_t OFF_WMKVT = OFF_WUKVT + (size_t)DEPTH * 512 * 128 * 2;
constexpr size_t OFF_MEMB = OFF_WMKVT + (size_t)DEPTH * 512 * 1024 * 2;
constexpr size_t OFF_MK = OFF_MEMB + (size_t)1024 * 1024 * 2;
constexpr size_t OFF_VTM = OFF_MK + (size_t)DEPTH * 1024 * 256 * 2;
constexpr size_t OFF_P = OFF_VTM + (size_t)DEPTH * 1024 * 256 * 2;
constexpr size_t OFF_VTA = OFF_P + (size_t)NTOK * PW * 2;
constexpr size_t VT_SZ = (size_t)NB * 4 * 64 * SEQ * 2;
constexpr size_t OFF_VTB = OFF_VTA + VT_SZ;
constexpr size_t OFF_VTC = OFF_VTB + VT_SZ;
constexpr size_t OFF_VTD = OFF_VTC + VT_SZ;
constexpr size_t OFF_IW = OFF_VTD + VT_SZ;
constexpr size_t OFF_QF = OFF_IW + (size_t)NTOK * 8 * 4;
constexpr size_t OFF_KN = OFF_QF + (size_t)NTOK * 384 * 2;
constexpr size_t OFF_KBAR = OFF_KN + (size_t)NTOK * 256 * 2;
constexpr size_t OFF_SC = OFF_KBAR + (size_t)NB * 4 * 32 * 64 * 2;
constexpr size_t OFF_Y = OFF_SC;
constexpr size_t OFF_MERGED = OFF_Y + (size_t)NTOK * 1280 * 2;
constexpr size_t OFF_MASK = OFF_SC + (size_t)NB * SC_PB * 4;
constexpr size_t OFF_ROPE = OFF_MASK + (size_t)NTOK * 128 * 4;
constexpr size_t OFF_BAR = OFF_ROPE + (size_t)SEQ * 56 * 4;
constexpr size_t WS_TOTAL = OFF_BAR + 16384;
constexpr int R_CS64 = 0, R_SN64 = SEQ * 8, R_CS32 = SEQ * 16, R_SN32 = SEQ * 20, R_CSM = SEQ * 24, R_SNM = SEQ * 40;

struct Params {
  const float *x, *mem, *ln0_g, *ln0_b, *w_in, *mla_q_norm, *w_uq, *mla_kv_norm, *w_ukv, *diff_lam, *diff_norm,
      *w_mem_kv, *w_branch, *w_out, *ln_g, *ln_b;
  float* out;
  char* ws;
};

typedef float f32x2_t __attribute__((ext_vector_type(2)));
typedef __bf16 bf16x2_t __attribute__((ext_vector_type(2)));
typedef uint32_t u32x4_t __attribute__((ext_vector_type(4)));
DI bf16 f2bf(float x) { return __builtin_bit_cast(bf16, (__bf16)x); }
DI float bf2f(bf16 v) { return __uint_as_float(((uint32_t)v) << 16); }
DI uint32_t pack2(float a, float b) { f32x2_t v = {a, b}; return __builtin_bit_cast(uint32_t, __builtin_convertvector(v, bf16x2_t)); }
DI bf16x8 pack8(const f32x16& x, int o) {
  u32x4_t w;
  w[0] = pack2(x[o], x[o + 1]); w[1] = pack2(x[o + 2], x[o + 3]); w[2] = pack2(x[o + 4], x[o + 5]); w[3] = pack2(x[o + 6], x[o + 7]);
  return __builtin_bit_cast(bf16x8, w);
}
DI int crow(int i, int h) { return (i & 3) + 8 * (i >> 2) + 4 * h; }
DI int pi_perm(int r) { return (r & 0x13) | ((r & 4) << 1) | ((r & 8) >> 1); }
DI int keyidx(int i, int h) { return (i & 3) + 4 * ((i >> 2) & 1) + 8 * h + 16 * (i >> 3); }
DI float fexp2(float x) { return __builtin_amdgcn_exp2f(x); }
DI bf16x8 ldg8(const bf16* p) { return *(const bf16x8*)p; }
DI f32x16 zero16() { f32x16 z; for (int i = 0; i < 16; ++i) z[i] = 0.f; return z; }

struct GStage { uint4 a0, a1, a2, a3, b0, b1, b2, b3; };
DI GStage gemm_issue(const bf16* __restrict__ A, int lda, const bf16* __restrict__ Bt, int ldb, int koff, int tid) {
  GStage g;
  const int srow = tid >> 3, sc = tid & 7;
  const bf16* ga = A + (size_t)srow * lda + sc * 8 + koff;
  const bf16* gb = Bt + (size_t)srow * ldb + sc * 8 + koff;
  const size_t sa32 = (size_t)32 * lda, sb32 = (size_t)32 * ldb;
  g.a0 = *(const uint4*)(ga); g.a1 = *(const uint4*)(ga + sa32); g.a2 = *(const uint4*)(ga + 2 * sa32); g.a3 = *(const uint4*)(ga + 3 * sa32);
  g.b0 = *(const uint4*)(gb); g.b1 = *(const uint4*)(gb + sb32); g.b2 = *(const uint4*)(gb + 2 * sb32); g.b3 = *(const uint4*)(gb + 3 * sb32);
  return g;
}
DI void gemm_stage(char* base, int soff, const GStage& g) {
  *(uint4*)(base + soff) = g.a0; *(uint4*)(base + soff + 4096) = g.a1; *(uint4*)(base + soff + 8192) = g.a2; *(uint4*)(base + soff + 12288) = g.a3;
  *(uint4*)(base + 16384 + soff) = g.b0; *(uint4*)(base + 16384 + soff + 4096) = g.b1;
  *(uint4*)(base + 16384 + soff + 8192) = g.b2; *(uint4*)(base + 16384 + soff + 12288) = g.b3;
}
DI void gemm_core(const bf16* __restrict__ A, int lda, const bf16* __restrict__ Bt, int ldb, int K,
                  f32x16 (&acc)[2][2], char* smem, int& tid_io, GStage g) {
  const int tid = tid_io;
  const int lane = tid & 63, wave = tid >> 6, wm = wave >> 1, wn = wave & 1;
  const int r = lane & 31, h = lane >> 5;
  const int srow = tid >> 3, sc = tid & 7;
  const int soff = srow * 128 + ((sc ^ ((srow >> 1) & 7)) << 4);
  const int KT = K >> 6;
  const int swz = (r >> 1) & 7;
  const int aoff = (wm * 64 + r) * 128, boff = 16384 + (wn * 64 + r) * 128;
  gemm_stage(smem, soff, g);
  __syncthreads();
#pragma unroll 1
  for (int kt = 0; kt < KT; ++kt) {
    if (kt + 1 < KT) g = gemm_issue(A, lda, Bt, ldb, (kt + 1) * 64, tid);
    const char* sbase = smem + (kt & 1) * 32768;
#pragma unroll
    for (int hh = 0; hh < 2; ++hh) {
      bf16x8 fa[2][2], fb[2][2];
#pragma unroll
      for (int k2 = 0; k2 < 2; ++k2) {
        const int co = (((hh * 2 + k2) * 2 + h) ^ swz) << 4;
        fa[k2][0] = *(const bf16x8*)(sbase + aoff + co);
        fb[k2][0] = *(const bf16x8*)(sbase + boff + co);
        fb[k2][1] = *(const bf16x8*)(sbase + boff + 4096 + co);
        fa[k2][1] = *(const bf16x8*)(sbase + aoff + 4096 + co);
      }
      __builtin_amdgcn_sched_barrier(0);
#pragma unroll
      for (int k2 = 0; k2 < 2; ++k2) {
        acc[0][0] = MFMA32(fa[k2][0], fb[k2][0], acc[0][0]);
        acc[0][1] = MFMA32(fa[k2][0], fb[k2][1], acc[0][1]);
        acc[1][0] = MFMA32(fa[k2][1], fb[k2][0], acc[1][0]);
        acc[1][1] = MFMA32(fa[k2][1], fb[k2][1], acc[1][1]);
      }
      __builtin_amdgcn_sched_barrier(0);
    }
    if (kt + 1 < KT) gemm_stage(smem + ((kt + 1) & 1) * 32768, soff, g);
    __syncthreads();
  }
  asm volatile("" : "+v"(tid_io) : : "memory");
}
template <int KT>
DI void gemm_core_u(const bf16* __restrict__ A, int lda, const bf16* __restrict__ Bt, int ldb,
                    f32x16 (&acc)[2][2], char* smem, int& tid_io, GStage g0) {
  const int tid = tid_io;
  const int lane = tid & 63, wave = tid >> 6, wm = wave >> 1, wn = wave & 1;
  const int r = lane & 31, h = lane >> 5;
  const int srow = tid >> 3, sc = tid & 7;
  const int soff = srow * 128 + ((sc ^ ((srow >> 1) & 7)) << 4);
  const int swz = (r >> 1) & 7;
  const int aoff = (wm * 64 + r) * 128, boff = 16384 + (wn * 64 + r) * 128;
  GStage gs[2];
  gs[0] = g0;
  gs[1] = gemm_issue(A, lda, Bt, ldb, 64, tid);
  gemm_stage(smem, soff, gs[0]);
  if (KT > 2) gs[0] = gemm_issue(A, lda, Bt, ldb, 128, tid);
  __syncthreads();
  bf16x8 xa0, xa1, xb0, xb1, ya0, ya1, yb0, yb1;
#define RDF(S, sb, q)                                                       \
  {                                                                         \
    const int co_ = (((q) * 2 + h) ^ swz) << 4;                             \
    S##a0 = *(const bf16x8*)((sb) + aoff + co_);                            \
    S##b0 = *(const bf16x8*)((sb) + boff + co_);                            \
    S##b1 = *(const bf16x8*)((sb) + boff + 4096 + co_);                     \
    S##a1 = *(const bf16x8*)((sb) + aoff + 4096 + co_);                     \
  }
#define MMF(S)                                                              \
  acc[0][0] = MFMA32(S##a0, S##b0, acc[0][0]);                              \
  acc[0][1] = MFMA32(S##a0, S##b1, acc[0][1]);                              \
  acc[1][0] = MFMA32(S##a1, S##b0, acc[1][0]);                              \
  acc[1][1] = MFMA32(S##a1, S##b1, acc[1][1]);
#define SB __builtin_amdgcn_sched_barrier(0);
  RDF(x, smem, 0)
#pragma unroll
  for (int kt = 0; kt < KT; ++kt) {
    const char* sbase = smem + (kt & 1) * 32768;
    SB RDF(y, sbase, 1) SB MMF(x) SB
    RDF(x, sbase, 2) SB MMF(y) SB
    RDF(y, sbase, 3) SB MMF(x) SB
    if (kt + 1 < KT) {
      gemm_stage(smem + ((kt + 1) & 1) * 32768, soff, gs[(kt + 1) & 1]);
      if (kt + 3 < KT) gs[(kt + 1) & 1] = gemm_issue(A, lda, Bt, ldb, (kt + 3) * 64, tid);
    }
    SB MMF(y) SB
    __syncthreads();
    if (kt + 1 < KT) { RDF(x, smem + ((kt + 1) & 1) * 32768, 0) }
  }
#undef RDF
#undef MMF
#undef SB
  asm volatile("" : "+v"(tid_io) : : "memory");
}
DI void gemm_full_loop(const bf16* __restrict__ A, int lda, const bf16* __restrict__ Bt, int ldb, int K,
                       f32x16 (&acc)[2][2], char* smem, int& tid_io) {
  GStage g = gemm_issue(A, lda, Bt, ldb, 0, tid_io);
  gemm_core(A, lda, Bt, ldb, K, acc, smem, tid_io, g);
}
template <int KT>
DI void gemm_full(const bf16* __restrict__ A, int lda, const bf16* __restrict__ Bt, int ldb,
                  f32x16 (&acc)[2][2], char* smem, int& tid_io) {
  GStage g = gemm_issue(A, lda, Bt, ldb, 0, tid_io);
  gemm_core_u<KT>(A, lda, Bt, ldb, acc, smem, tid_io, g);
}

DI void store_rm(bf16* dst, int ld, int rowb, int col, const f32x16& v, int h) {
#pragma unroll
  for (int i = 0; i < 16; ++i) dst[(size_t)(rowb + crow(i, h)) * ld + col] = f2bf(v[i]);
}
DI void store_vt(bf16* vt, int tstride, int d, int t0, const f32x16& v, int h) {
#pragma unroll
  for (int g = 0; g < 4; ++g) {
    uint2 w;
    w.x = pack2(v[4 * g], v[4 * g + 1]);
    w.y = pack2(v[4 * g + 2], v[4 * g + 3]);
    *(uint2*)(vt + (size_t)d * tstride + t0 + 8 * g + 4 * h) = w;
  }
}
template <int XR>
DI void rope_tile(f32x16& v, int r, int h, int rowb, const float* cs, const float* sn) {
  const int f = r & (XR - 1);
  const int tb = (rowb & (SEQ - 1)) + 4 * h;
#pragma unroll
  for (int i = 0; i < 16; ++i) {
    float pv = __shfl_xor(v[i], XR);
    if (r < 2 * XR) {
      const int idx = (tb + (i & 3) + 8 * (i >> 2)) * XR + f;
      float c = cs[idx], s = sn[idx];
      v[i] = (r < XR) ? (v[i] * c - pv * s) : (v[i] * c + pv * s);
    }
  }
}

DI void ln_rows(const float* src, const float* g, const float* b, float* dstf, bf16* dstb, int tid) {
  const int lane = tid & 63, wave = tid >> 6;
  for (int row = blockIdx.x * 4 + wave; row < NTOK; row += gridDim.x * 4) {
    const float4* s4 = (const float4*)(src + (size_t)row * DM);
    float4 v[4];
    float sum = 0.f;
#pragma unroll
    for (int j = 0; j < 4; ++j) { v[j] = s4[lane + 64 * j]; sum += v[j].x + v[j].y + v[j].z + v[j].w; }
#pragma unroll
    for (int o = 32; o >= 1; o >>= 1) sum += __shfl_xor(sum, o);
    float mu = sum * (1.f / DM);
    float sq = 0.f;
#pragma unroll
    for (int j = 0; j < 4; ++j) {
      float a = v[j].x - mu, bb = v[j].y - mu, c = v[j].z - mu, d = v[j].w - mu;
      sq += a * a + bb * bb + c * c + d * d;
    }
#pragma unroll
    for (int o = 32; o >= 1; o >>= 1) sq += __shfl_xor(sq, o);
    float rstd = rsqrtf(sq * (1.f / DM) + 1e-5f);
#pragma unroll
    for (int j = 0; j < 4; ++j) {
      int c0 = (lane + 64 * j) * 4;
      float4 gg = *(const float4*)(g + c0), bb = *(const float4*)(b + c0);
      float4 o;
      o.x = (v[j].x - mu) * rstd * gg.x + bb.x;
      o.y = (v[j].y - mu) * rstd * gg.y + bb.y;
      o.z = (v[j].z - mu) * rstd * gg.z + bb.z;
      o.w = (v[j].w - mu) * rstd * gg.w + bb.w;
      *(float4*)(dstf + (size_t)row * DM + c0) = o;
      uint2 w; w.x = pack2(o.x, o.y); w.y = pack2(o.z, o.w);
      *(uint2*)(dstb + (size_t)row * DM + c0) = w;
    }
  }
}

DI int wcol_of(int n) {
  if (n < 1024) return n;
  if (n < 1056) return 9600 + (n - 1024);
  if (n < 1064) return 9664 + (n - 1056);
  if (n < 2600) return n - 40;
  if (n < 2856) return n - 2600 + 2560;
  if (n < 2984) return n - 2856 + 9472;
  if (n < 3016) return n - 2984 + 9632;
  if (n < 3272) return n - 3016 + 2816;
  return n - 200;
}

template <bool MAPW>
DI void conv_tile(const float* src, int K, int N, bf16* dst, const float* rowscale, char* smem, int tid, int t) {
  float* lds = (float*)smem;
  const int ktiles = K >> 6;
  const int k0 = (t % ktiles) * 64, n0 = (t / ktiles) * 64;
  const int tx = (tid & 15) * 4, ty = tid >> 4;
  float4 v[4];
#pragma unroll
  for (int i = 0; i < 4; ++i) {
    const int k = ty + 16 * i;
    v[i] = (n0 + tx < N) ? *(const float4*)(src + (size_t)(k0 + k) * N + n0 + tx) : make_float4(0.f, 0.f, 0.f, 0.f);
  }
#pragma unroll
  for (int i = 0; i < 4; ++i) {
    const int k = ty + 16 * i;
    const float rsc = rowscale ? rowscale[k0 + k] : 1.f;
    lds[k * 65 + tx] = v[i].x * rsc; lds[k * 65 + tx + 1] = v[i].y * rsc;
    lds[k * 65 + tx + 2] = v[i].z * rsc; lds[k * 65 + tx + 3] = v[i].w * rsc;
  }
  __syncthreads();
  const int nl = tid >> 2, kc = tid & 3;
  if (n0 + nl < N) {
    const int nd = MAPW ? wcol_of(n0 + nl) : (n0 + nl);
    uint32_t w[8];
#pragma unroll
    for (int jj = 0; jj < 8; ++jj) w[jj] = pack2(lds[(kc * 16 + 2 * jj) * 65 + nl], lds[(kc * 16 + 2 * jj + 1) * 65 + nl]);
    uint4* d4 = (uint4*)(dst + (size_t)nd * K + k0 + kc * 16);
    d4[0] = make_uint4(w[0], w[1], w[2], w[3]);
    d4[1] = make_uint4(w[4], w[5], w[6], w[7]);
  }
  __syncthreads();
}
template <bool MAPW>
DI void conv_matrix(const float* src, int K, int N, bf16* dst, const float* rowscale, char* smem, int tid) {
  const int ntl = (K >> 6) * ((N + 63) >> 6);
  for (int t = blockIdx.x; t < ntl; t += gridDim.x) conv_tile<MAPW>(src, K, N, dst, rowscale, smem, tid, t);
}

DI void st8(bf16* dst, const float (&x)[8]) {
  uint4 w;
  w.x = pack2(x[0], x[1]); w.y = pack2(x[2], x[3]); w.z = pack2(x[4], x[5]); w.w = pack2(x[6], x[7]);
  *(uint4*)dst = w;
}
DI void ld8(const float* src, float (&x)[8]) {
  float4 a = *(const float4*)src, b = *(const float4*)(src + 4);
  x[0] = a.x; x[1] = a.y; x[2] = a.z; x[3] = a.w; x[4] = b.x; x[5] = b.y; x[6] = b.z; x[7] = b.w;
}
DI void epi_inproj(const Params& p, f32x16 (&acc)[2][2], int mt, int ct, int tid, char* smem) {
  float* C = (float*)smem;
  {
    const int lane = tid & 63, wave = tid >> 6, wm = wave >> 1, wn = wave & 1, r = lane & 31, h = lane >> 5;
#pragma unroll
    for (int mi = 0; mi < 2; ++mi)
#pragma unroll
      for (int ni = 0; ni < 2; ++ni)
#pragma unroll
        for (int i = 0; i < 16; ++i)
          C[(wm * 64 + mi * 32 + crow(i, h)) * 128 + wn * 64 + ni * 32 + r] = acc[mi][ni][i];
  }
  __syncthreads();
  bf16* P = (bf16*)(p.ws + OFF_P);
  const float* rope = (const float*)(p.ws + OFF_ROPE);
  const int m0 = mt * 128;
  const int seg = ct >> 1;
  if (ct < 24 && (seg == 2 || seg == 6 || seg == 9)) {
    const size_t off = seg == 2 ? OFF_VTA : (seg == 6 ? OFF_VTB : OFF_VTC);
    const int col = tid & 127;
    const int cs = (ct & 1) * 128 + col;
    bf16* vt = (bf16*)(p.ws + off) + ((size_t)((m0 >> 12) * 4 + (cs >> 6)) * 64 + (cs & 63)) * SEQ + (m0 & (SEQ - 1));
#pragma unroll
    for (int ps = 0; ps < 8; ++ps) {
      const int rg = (tid >> 7) + 2 * ps;
      float x[8];
#pragma unroll
      for (int e = 0; e < 8; ++e) x[e] = C[(rg * 8 + e) * 128 + col];
      st8(vt + rg * 8, x);
    }
  } else {
    const int c0 = (tid & 15) * 8;
    int mode, pcol;
    if (ct < 24) {
      switch (seg) {
        case 0: pcol = P_AQ; mode = 1; break;  case 1: pcol = P_AK; mode = 1; break;
        case 3: pcol = P_IQ; mode = 2; break;  case 4: pcol = P_BQ; mode = 1; break;
        case 5: pcol = P_BK; mode = 1; break;  case 7: pcol = P_CQ; mode = 2; break;
        case 8: pcol = P_CK; mode = 2; break;  case 10: pcol = P_DCQ; mode = 0; break;
        default: pcol = P_EQ; mode = 0; break;
      }
      pcol += (ct & 1) * 128;
    } else if (ct < 34) { mode = 3; pcol = P_Z + (ct - 24) * 128; }
    else if (ct < 74) { mode = 4; pcol = P_G + (ct - 34) * 128; }
    else if (ct == 74) { mode = 0; pcol = P_DCKV; }
    else { mode = 5; pcol = P_IK; }
#pragma unroll 1
    for (int ps = 0; ps < 8; ++ps) {
      const int row = ps * 16 + (tid >> 4);
      const int t = (m0 + row) & (SEQ - 1);
      float x[8];
      ld8(C + row * 128 + c0, x);
      bf16* dst = P + (size_t)(m0 + row) * PW + pcol + c0;
      if (mode == 3) {
#pragma unroll
        for (int e = 0; e < 8; ++e) x[e] = x[e] * __builtin_amdgcn_rcpf(1.f + __expf(-x[e]));
      } else if (mode == 4) {
#pragma unroll
        for (int e = 0; e < 8; ++e) x[e] = __builtin_amdgcn_rcpf(1.f + __expf(-x[e]));
      } else if (mode == 1) {
        const int hc = c0 & 63;
        if (hc < 16) {
          float y[8], c[8], sn[8];
          ld8(C + row * 128 + (c0 ^ 8), y);
          ld8(rope + R_CS64 + t * 8, c);
          ld8(rope + R_SN64 + t * 8, sn);
#pragma unroll
          for (int e = 0; e < 8; ++e) x[e] = (hc == 0) ? (x[e] * c[e] - y[e] * sn[e]) : (x[e] * c[e] + y[e] * sn[e]);
        }
      } else if (mode == 2 || (mode == 5 && c0 == 0)) {
        if ((c0 & 31) == 0) {
          float4 c = *(const float4*)(rope + R_CS32 + t * 4), sn = *(const float4*)(rope + R_SN32 + t * 4);
          float a0 = x[0], a1 = x[1], a2 = x[2], a3 = x[3], b0 = x[4], b1 = x[5], b2 = x[6], b3 = x[7];
          x[0] = a0 * c.x - b0 * sn.x; x[1] = a1 * c.y - b1 * sn.y; x[2] = a2 * c.z - b2 * sn.z; x[3] = a3 * c.w - b3 * sn.w;
          x[4] = b0 * c.x + a0 * sn.x; x[5] = b1 * c.y + a1 * sn.y; x[6] = b2 * c.z + a2 * sn.z; x[7] = b3 * c.w + a3 * sn.w;
        }
      } else if (mode == 5) {
        if (c0 >= 32 && c0 < 64) {
          const int hc = c0 - 32;
          float y[8], c[8], sn[8];
          ld8(C + row * 128 + 32 + (hc ^ 16), y);
          ld8(rope + R_CSM + t * 16 + (hc & 15), c);
          ld8(rope + R_SNM + t * 16 + (hc & 15), sn);
#pragma unroll
          for (int e = 0; e < 8; ++e) x[e] = (hc < 16) ? (x[e] * c[e] - y[e] * sn[e]) : (x[e] * c[e] + y[e] * sn[e]);
        }
      }
      if (mode != 5 || c0 < 64) {
        st8(dst, x);
      } else if (c0 == 64) {
        float* iw = (float*)(p.ws + OFF_IW) + (size_t)(m0 + row) * 8;
        *(float4*)iw = make_float4(x[0], x[1], x[2], x[3]);
        *(float4*)(iw + 4) = make_float4(x[4], x[5], x[6], x[7]);
      }
    }
  }
  __syncthreads();
}

struct AttnArgs {
  const bf16* Q; int qs;
  const bf16* K1; int k1s;
  const bf16* K2; int k2s;
  const bf16* Vt; int vts;
  int q0;
  float sc;
  const uint32_t* mask;
  const bf16* kbar;
};

#ifndef ZERO_BR
#define ZERO_BR -1
#endif
DI void attn_store(const Params& p, const f32x16 (&o)[2], float inv, int row, int br, int head, int lane) {
  const int h = lane >> 5;
  if (br == ZERO_BR) inv = 0.f;
  const bf16* P = (const bf16*)(p.ws + OFF_P);
  bf16* Y = (bf16*)(p.ws + OFF_Y);
#pragma unroll
  for (int dt = 0; dt < 2; ++dt)
#pragma unroll
    for (int g = 0; g < 4; ++g) {
      int d0 = dt * 32 + 8 * g + 4 * h;
      int c = br * 256 + head * 64 + d0;
      uint2 zz = *(const uint2*)(P + (size_t)row * PW + P_Z + c);
      float z0 = bf2f((bf16)(zz.x & 0xffff)), z1 = bf2f((bf16)(zz.x >> 16));
      float z2 = bf2f((bf16)(zz.y & 0xffff)), z3 = bf2f((bf16)(zz.y >> 16));
      uint2 w;
      w.x = pack2(o[dt][4 * g] * inv * z0, o[dt][4 * g + 1] * inv * z1);
      w.y = pack2(o[dt][4 * g + 2] * inv * z2, o[dt][4 * g + 3] * inv * z3);
      *(uint2*)(Y + (size_t)row * 1280 + c) = w;
    }
}

DI float xh_max(float v) {
  auto rr = __builtin_amdgcn_permlane32_swap(__float_as_uint(v), __float_as_uint(v), false, false);
  return fmaxf(__uint_as_float(rr[0]), __uint_as_float(rr[1]));
}
DI float xh_sum(float v) {
  auto rr = __builtin_amdgcn_permlane32_swap(__float_as_uint(v), __float_as_uint(v), false, false);
  return __uint_as_float(rr[0]) + __uint_as_float(rr[1]);
}
template <int MODE, int NKS1, int NKS2>
DI void attn_std(const Params& p, const AttnArgs& a, int ntiles, int lane, int br, int head, int rowbase) {
  f32x16 o[2][2];
  constexpr int NKS = NKS1 + NKS2;
  const int r = lane & 31, h = lane >> 5;
  bf16x8 qf[2][NKS];
#pragma unroll
  for (int qi = 0; qi < 2; ++qi)
#pragma unroll
    for (int ks = 0; ks < NKS; ++ks) qf[qi][ks] = ldg8(a.Q + (size_t)(a.q0 + 32 * qi + r) * a.qs + ks * 16 + 8 * h);
  float m[2] = {-INFINITY, -INFINITY}, l[2] = {0.f, 0.f};
#pragma unroll
  for (int qi = 0; qi < 2; ++qi) { o[qi][0] = zero16(); o[qi][1] = zero16(); }
  const int pr = pi_perm(r);
  uint32_t selmask[2] = {0u, 0u};
  const int own = a.q0 >> 8;
  uint32_t blkmask = 0xffffffffu;
  if (MODE == 3) {
    bf16x8 kbf[4];
#pragma unroll
    for (int ks = 0; ks < 4; ++ks) kbf[ks] = ldg8(a.kbar + (size_t)(r & 15) * 64 + ks * 16 + 8 * h);
    blkmask = 1u << own;
#pragma unroll
    for (int qi = 0; qi < 2; ++qi) {
      f32x16 g = zero16();
#pragma unroll
      for (int ks = 0; ks < 4; ++ks) g = MFMA32(kbf[ks], qf[qi][ks], g);
      float mine[8], part[8];
#pragma unroll
      for (int i = 0; i < 8; ++i) { mine[i] = g[i]; part[i] = __shfl_xor(g[i], 32); }
      uint32_t sm = 0u;
#pragma unroll
      for (int it = 0; it < 3; ++it) {
        float best = -INFINITY; int bi = -1;
#pragma unroll
        for (int n = 0; n < 16; ++n) {
          const int i = (n & 3) + 4 * (n >> 3);
          float gv = (((n >> 2) & 1) == h) ? mine[i] : part[i];
          bool ok = (n < own) && !((sm >> n) & 1u) && (gv > best);
          if (ok) { best = gv; bi = n; }
        }
        if (bi >= 0) sm |= 1u << bi;
      }
      selmask[qi] = sm;
#pragma unroll
      for (int n = 0; n < 16; ++n)
        if (__ballot((sm >> n) & 1u) != 0ull) blkmask |= 1u << n;
    }
  }
  auto advance = [&](int kt) {
    ++kt;
    if (MODE == 3) { while (kt < ntiles && !((blkmask >> (kt >> 3)) & 1u)) kt = (kt | 7) + 1; }
    return kt;
  };
  bf16x8 kf[NKS];
  uint32_t mw[2] = {0u, 0u};
  int kt = advance(-1);
  {
    const int key = kt * 32 + pr;
#pragma unroll
    for (int ks = 0; ks < NKS1; ++ks) kf[ks] = ldg8(a.K1 + (size_t)key * a.k1s + ks * 16 + 8 * h);
#pragma unroll
    for (int ks = 0; ks < NKS2; ++ks) kf[NKS1 + ks] = ldg8(a.K2 + (size_t)key * a.k2s + ks * 16 + 8 * h);
    if (MODE == 2) { mw[0] = a.mask[(size_t)(a.q0 + r) * 128 + kt]; mw[1] = a.mask[(size_t)(a.q0 + 32 + r) * 128 + kt]; }
  }
  while (kt < ntiles) {
    const int nxt = advance(kt);
    const int ktn = nxt < ntiles ? nxt : kt;
    bf16x8 kfn[NKS], vf[2][2];
    uint32_t mwn[2] = {0u, 0u};
    {
      const int key = ktn * 32 + pr;
#pragma unroll
      for (int ks = 0; ks < NKS1; ++ks) kfn[ks] = ldg8(a.K1 + (size_t)key * a.k1s + ks * 16 + 8 * h);
#pragma unroll
      for (int ks = 0; ks < NKS2; ++ks) kfn[NKS1 + ks] = ldg8(a.K2 + (size_t)key * a.k2s + ks * 16 + 8 * h);
#pragma unroll
      for (int s = 0; s < 2; ++s)
#pragma unroll
        for (int dt = 0; dt < 2; ++dt) vf[s][dt] = ldg8(a.Vt + (size_t)(dt * 32 + r) * a.vts + kt * 32 + 16 * s + 8 * h);
      if (MODE == 2) { mwn[0] = a.mask[(size_t)(a.q0 + r) * 128 + ktn]; mwn[1] = a.mask[(size_t)(a.q0 + 32 + r) * 128 + ktn]; }
    }
#pragma unroll
    for (int qi = 0; qi < 2; ++qi) {
      const int qd = (a.q0 >> 5) + qi;
      if (MODE != 1 && kt > qd) continue;
      bool lane_ok = true;
      if (MODE == 3) {
        const int jb = kt >> 3;
        if (jb < own) lane_ok = (selmask[qi] >> jb) & 1u;
      }
      f32x16 sacc = zero16();
#pragma unroll
      for (int ks = 0; ks < NKS; ++ks) sacc = MFMA32(kf[ks], qf[qi][ks], sacc);
      const bool diag = (MODE == 0 || MODE == 3) && (kt == qd);
      float mloc = -INFINITY;
      if (MODE == 2 || diag || (MODE == 3 && (kt >> 3) < own)) {
#pragma unroll
        for (int i = 0; i < 16; ++i) {
          bool ok = lane_ok;
          if (diag) ok = ok && (keyidx(i, h) <= r);
          if (MODE == 2) ok = (mw[qi] >> keyidx(i, h)) & 1u;
          float sv = ok ? sacc[i] : -INFINITY;
          sacc[i] = sv;
          mloc = fmaxf(mloc, sv);
        }
      } else {
#pragma unroll
        for (int i = 0; i < 16; ++i) mloc = fmaxf(mloc, sacc[i]);
      }
      mloc = xh_max(mloc) * a.sc;
      const float mnew = fmaxf(m[qi], mloc);
      const float muse = (mnew == -INFINITY) ? 0.f : mnew;
      const float alpha = fexp2(m[qi] - muse);
      m[qi] = mnew;
      float psum = 0.f;
#pragma unroll
      for (int i = 0; i < 16; ++i) { float pv = fexp2(fmaf(sacc[i], a.sc, -muse)); sacc[i] = pv; psum += pv; }
      l[qi] = l[qi] * alpha + psum;
      if (__ballot(alpha != 1.f) != 0ull) {
#pragma unroll
        for (int i = 0; i < 16; ++i) { o[qi][0][i] *= alpha; o[qi][1][i] *= alpha; }
      }
#pragma unroll
      for (int s = 0; s < 2; ++s) {
        const bf16x8 pf = pack8(sacc, 8 * s);
        o[qi][0] = MFMA32(vf[s][0], pf, o[qi][0]);
        o[qi][1] = MFMA32(vf[s][1], pf, o[qi][1]);
      }
    }
#pragma unroll
    for (int ks = 0; ks < NKS; ++ks) kf[ks] = kfn[ks];
    mw[0] = mwn[0]; mw[1] = mwn[1];
    kt = nxt;
  }
  attn_store(p, o[0], 1.f / xh_sum(l[0]), rowbase + a.q0 + r, br, head, lane);
  attn_store(p, o[1], 1.f / xh_sum(l[1]), rowbase + a.q0 + 32 + r, br, head, lane);
}

DI void attn_diff(const Params& p, int layer, int b, int head, int q0, int lane) {
  const int r = lane & 31, h = lane >> 5;
  const bf16* P = (const bf16*)(p.ws + OFF_P);
  const bf16* Qb = P + (size_t)b * SEQ * PW + P_CQ + head * 64;
  const bf16* Kb = P + (size_t)b * SEQ * PW + P_CK + head * 64;
  const bf16* Vt = (const bf16*)(p.ws + OFF_VTC) + (size_t)(b * 4 + head) * 64 * SEQ;
  const int q = q0 + r;
  bf16x8 qf[4];
#pragma unroll
  for (int ks = 0; ks < 4; ++ks) qf[ks] = ldg8(Qb + (size_t)q * PW + ks * 16 + 8 * h);
  f32x16 o1[2], o2[2];
  o1[0] = zero16(); o1[1] = zero16(); o2[0] = zero16(); o2[1] = zero16();
  float m1 = -INFINITY, l1 = 0.f, m2 = -INFINITY, l2 = 0.f;
  const float sc = 0.17677669529663687f * LOG2E;
  const int pr = pi_perm(r);
  const int ntiles = (q0 >> 5) + 1;
  bf16x8 kf[4], vf[2][2];
  {
    const int key = pr;
#pragma unroll
    for (int ks = 0; ks < 4; ++ks) kf[ks] = ldg8(Kb + (size_t)key * PW + ks * 16 + 8 * h);
#pragma unroll
    for (int s = 0; s < 2; ++s)
#pragma unroll
      for (int dt = 0; dt < 2; ++dt) vf[s][dt] = ldg8(Vt + (size_t)(dt * 32 + r) * SEQ + 16 * s + 8 * h);
  }
  for (int kt = 0; kt < ntiles; ++kt) {
    const int ktn = (kt + 1 < ntiles) ? kt + 1 : kt;
    bf16x8 kfn[4], vfn[2][2];
    {
      const int key = ktn * 32 + pr;
#pragma unroll
      for (int ks = 0; ks < 4; ++ks) kfn[ks] = ldg8(Kb + (size_t)key * PW + ks * 16 + 8 * h);
#pragma unroll
      for (int s = 0; s < 2; ++s)
#pragma unroll
        for (int dt = 0; dt < 2; ++dt) vfn[s][dt] = ldg8(Vt + (size_t)(dt * 32 + r) * SEQ + ktn * 32 + 16 * s + 8 * h);
    }
    f32x16 s1 = zero16(), s2 = zero16();
    s1 = MFMA32(kf[0], qf[0], s1); s1 = MFMA32(kf[1], qf[1], s1);
    s2 = MFMA32(kf[2], qf[2], s2); s2 = MFMA32(kf[3], qf[3], s2);
    const bool diag = (kt == ntiles - 1);
    float ml1 = -INFINITY, ml2 = -INFINITY;
#pragma unroll
    for (int i = 0; i < 16; ++i) {
      bool ok = !diag || (keyidx(i, h) <= r);
      float a = ok ? s1[i] * sc : -INFINITY, c = ok ? s2[i] * sc : -INFINITY;
      s1[i] = a; s2[i] = c;
      ml1 = fmaxf(ml1, a); ml2 = fmaxf(ml2, c);
    }
    ml1 = xh_max(ml1);
    ml2 = xh_max(ml2);
    float mn1 = fmaxf(m1, ml1), mn2 = fmaxf(m2, ml2);
    float al1 = fexp2(m1 - mn1), al2 = fexp2(m2 - mn2);
    m1 = mn1; m2 = mn2;
    float ps1 = 0.f, ps2 = 0.f;
#pragma unroll
    for (int i = 0; i < 16; ++i) {
      float a = fexp2(s1[i] - mn1), c = fexp2(s2[i] - mn2);
      s1[i] = a; s2[i] = c; ps1 += a; ps2 += c;
    }
    l1 = l1 * al1 + ps1; l2 = l2 * al2 + ps2;
    if (__ballot((al1 != 1.f) || (al2 != 1.f)) != 0ull)
#pragma unroll
    for (int i = 0; i < 16; ++i) { o1[0][i] *= al1; o1[1][i] *= al1; o2[0][i] *= al2; o2[1][i] *= al2; }
#pragma unroll
    for (int s = 0; s < 2; ++s) {
      const bf16x8 p1 = pack8(s1, 8 * s), p2 = pack8(s2, 8 * s);
      o1[0] = MFMA32(vf[s][0], p1, o1[0]); o1[1] = MFMA32(vf[s][1], p1, o1[1]);
      o2[0] = MFMA32(vf[s][0], p2, o2[0]); o2[1] = MFMA32(vf[s][1], p2, o2[1]);
    }
#pragma unroll
    for (int ks = 0; ks < 4; ++ks) kf[ks] = kfn[ks];
#pragma unroll
    for (int s = 0; s < 2; ++s) { vf[s][0] = vfn[s][0]; vf[s][1] = vfn[s][1]; }
  }
  l1 = xh_sum(l1); l2 = xh_sum(l2);
  const float* dl = p.diff_lam + (size_t)layer * 128;
  float d01 = dl[r] * dl[32 + r], d23 = dl[64 + r] * dl[96 + r];
#pragma unroll
  for (int off = 16; off >= 1; off >>= 1) { d01 += __shfl_xor(d01, off); d23 += __shfl_xor(d23, off); }
  const float lam_init = 0.8f - 0.6f * expf(-0.3f * (float)layer);
  const float lam = expf(d01) - expf(d23) + lam_init;
  const float i1 = 1.f / l1, i2 = lam / l2;
  float ss = 0.f;
#pragma unroll
  for (int dt = 0; dt < 2; ++dt)
#pragma unroll
    for (int i = 0; i < 16; ++i) { float v = o1[dt][i] * i1 - o2[dt][i] * i2; o1[dt][i] = v; ss += v * v; }
  ss += __shfl_xor(ss, 32);
  const float rs = rsqrtf(ss * (1.f / 64.f) + 1e-6f) * (1.f - lam_init);
  const float* dn = p.diff_norm + (size_t)layer * 64;
#pragma unroll
  for (int dt = 0; dt < 2; ++dt)
#pragma unroll
    for (int i = 0; i < 16; ++i) o1[dt][i] *= dn[dt * 32 + crow(i, h)];
  attn_store(p, o1, rs, b * SEQ + q, 2, head, lane);
}

constexpr int AT_STAGE = 20480;
struct AtRegs { uint4 k0, k1, v0, v1, kr; };

template <int NKS2>
DI AtRegs at_issue(const AttnArgs& a, int kt, int tid) {
  AtRegs g;
  const int row = tid >> 3, c = tid & 7;
  const bf16* kp = a.K1 + (size_t)(kt * 64 + row) * a.k1s + c * 8;
  g.k0 = *(const uint4*)kp;
  g.k1 = *(const uint4*)(kp + (size_t)32 * a.k1s);
  const bf16* vp = a.Vt + (size_t)row * a.vts + kt * 64 + c * 8;
  g.v0 = *(const uint4*)vp;
  g.v1 = *(const uint4*)(vp + (size_t)32 * a.vts);
  if (NKS2) g.kr = *(const uint4*)(a.K2 + (size_t)(kt * 64 + (tid >> 2)) * a.k2s + (tid & 3) * 8);
  else g.kr = make_uint4(0u, 0u, 0u, 0u);
  return g;
}
template <int NKS2>
DI void at_stage(char* st, const AtRegs& g, int tid) {
  const int row = tid >> 3, c = tid & 7;
  const int off = row * 128 + ((c ^ ((row >> 1) & 7)) << 4);
  *(uint4*)(st + off) = g.k0;
  *(uint4*)(st + off + 4096) = g.k1;
  *(uint4*)(st + 8192 + off) = g.v0;
  *(uint4*)(st + 8192 + off + 4096) = g.v1;
  if (NKS2) {
    const int r2 = tid >> 2, c2 = tid & 3;
    *(uint4*)(st + 16384 + r2 * 64 + ((c2 ^ ((r2 >> 2) & 3)) << 4)) = g.kr;
  }
}

template <int MODE, int NKS2>
DI void attn_blk_std(const Params& p, const AttnArgs& a, int nt_none, int tid, int br, int head, int rowbase, char* smem, unsigned* s_blk) {
  constexpr int NKS = 4 + NKS2;
  const int lane = tid & 63, wave = tid >> 6, r = lane & 31, h = lane >> 5;
  const int q0w = a.q0 + wave * 64;
  bf16x8 qf[2][NKS];
#pragma unroll
  for (int qi = 0; qi < 2; ++qi)
#pragma unroll
    for (int ks = 0; ks < NKS; ++ks) qf[qi][ks] = ldg8(a.Q + (size_t)(q0w + 32 * qi + r) * a.qs + ks * 16 + 8 * h);
  f32x16 o[2][2];
  float m[2] = {-INFINITY, -INFINITY}, l[2] = {0.f, 0.f};
#pragma unroll
  for (int qi = 0; qi < 2; ++qi) { o[qi][0] = zero16(); o[qi][1] = zero16(); }
  const int pr = pi_perm(r);
  uint32_t selmask[2] = {0u, 0u};
  uint32_t qmask[2] = {0u, 0u};
  const int own = a.q0 >> 8;
  uint32_t blkmask = 0xffffffffu;
  if (MODE == 3) {
    bf16x8 kbf[4];
#pragma unroll
    for (int ks = 0; ks < 4; ++ks) kbf[ks] = ldg8(a.kbar + (size_t)(r & 15) * 64 + ks * 16 + 8 * h);
    uint32_t wmask = 0u;
#pragma unroll
    for (int qi = 0; qi < 2; ++qi) {
      f32x16 g = zero16();
#pragma unroll
      for (int ks = 0; ks < 4; ++ks) g = MFMA32(kbf[ks], qf[qi][ks], g);
      float mine[8], part[8];
#pragma unroll
      for (int i = 0; i < 8; ++i) { mine[i] = g[i]; part[i] = __shfl_xor(g[i], 32); }
      uint32_t sm = 0u;
#pragma unroll
      for (int it = 0; it < 3; ++it) {
        float best = -INFINITY; int bi = -1;
#pragma unroll
        for (int n = 0; n < 16; ++n) {
          const int i = (n & 3) + 4 * (n >> 3);
          float gv = (((n >> 2) & 1) == h) ? mine[i] : part[i];
          bool ok = (n < own) && !((sm >> n) & 1u) && (gv > best);
          if (ok) { best = gv; bi = n; }
        }
        if (bi >= 0) sm |= 1u << bi;
      }
      selmask[qi] = sm;
      uint32_t um = 0u;
#pragma unroll
      for (int n = 0; n < 16; ++n)
        if (__ballot((sm >> n) & 1u) != 0ull) um |= 1u << n;
      qmask[qi] = um;
      wmask |= um;
    }
    if (tid == 0) *s_blk = 1u << own;
    __syncthreads();
    if (lane == 0) atomicOr(s_blk, wmask);
    __syncthreads();
    blkmask = *s_blk;
  }
  const int nt = (MODE == 1) ? nt_none : ((a.q0 + 255) >> 6) + 1;
  auto advance = [&](int kt) {
    ++kt;
    if (MODE == 3) { while (kt < nt && !((blkmask >> (kt >> 2)) & 1u)) kt = (kt | 3) + 1; }
    return kt;
  };
  const int koff = pr * 128, kswz = (pr >> 1) & 7;
  const int kroff = 16384 + pr * 64, krswz = (pr >> 2) & 3;
  const int voff = 8192 + r * 128, vswz = (r >> 1) & 7;
  int kt = advance(-1);
  AtRegs g = at_issue<NKS2>(a, kt, tid);
  at_stage<NKS2>(smem, g, tid);
  int kt1 = advance(kt);
  if (kt1 < nt) g = at_issue<NKS2>(a, kt1, tid);
  uint2 mwn[2] = {make_uint2(0u, 0u), make_uint2(0u, 0u)};
  if (MODE == 2) {
    mwn[0] = *(const uint2*)(a.mask + (size_t)(q0w + r) * 128 + 2 * kt);
    mwn[1] = *(const uint2*)(a.mask + (size_t)(q0w + 32 + r) * 128 + 2 * kt);
  }
  __syncthreads();
  int buf = 0;
  while (kt < nt) {
    const int kt2 = (kt1 < nt) ? advance(kt1) : nt;
    const char* st = smem + buf * AT_STAGE;
    uint2 mw[2] = {mwn[0], mwn[1]};
    if (MODE == 2 && kt1 < nt) {
      mwn[0] = *(const uint2*)(a.mask + (size_t)(q0w + r) * 128 + 2 * kt1);
      mwn[1] = *(const uint2*)(a.mask + (size_t)(q0w + 32 + r) * 128 + 2 * kt1);
    }
#pragma unroll
    for (int qi = 0; qi < 2; ++qi) {
      const int qfirst = q0w + 32 * qi;
      if (MODE != 1 && 64 * kt > qfirst + 31) continue;
      if (MODE == 3 && (kt >> 2) < own && !((qmask[qi] >> (kt >> 2)) & 1u)) continue;
      bool lane_ok = true;
      if (MODE == 3) {
        const int jb = kt >> 2;
        if (jb < own) lane_ok = (selmask[qi] >> jb) & 1u;
      }
      f32x16 sacc[2];
#pragma unroll
      for (int ksub = 0; ksub < 2; ++ksub) {
        bf16x8 kf[NKS];
#pragma unroll
        for (int ks = 0; ks < 4; ++ks) kf[ks] = *(const bf16x8*)(st + ksub * 4096 + koff + (((ks * 2 + h) ^ kswz) << 4));
#pragma unroll
        for (int ks = 0; ks < NKS2; ++ks) kf[4 + ks] = *(const bf16x8*)(st + ksub * 2048 + kroff + (((ks * 2 + h) ^ krswz) << 4));
        f32x16 sa = zero16();
#pragma unroll
        for (int ks = 0; ks < NKS; ++ks) sa = MFMA32(kf[ks], qf[qi][ks], sa);
        sacc[ksub] = sa;
      }
      const bool diag = (MODE == 0 || MODE == 3) && (64 * kt + 63 > qfirst);
      float mloc = -INFINITY;
      if (MODE == 2 || diag) {
#pragma unroll
        for (int ksub = 0; ksub < 2; ++ksub)
#pragma unroll
          for (int i = 0; i < 16; ++i) {
            bool ok = lane_ok;
            if (diag) ok = ok && (64 * kt + 32 * ksub + keyidx(i, h) <= qfirst + r);
            if (MODE == 2) ok = ((ksub ? mw[qi].y : mw[qi].x) >> keyidx(i, h)) & 1u;
            float sv = ok ? sacc[ksub][i] : -INFINITY;
            sacc[ksub][i] = sv;
            mloc = fmaxf(mloc, sv);
          }
      } else {
#pragma unroll
        for (int i = 0; i < 16; ++i) mloc = fmaxf(mloc, fmaxf(sacc[0][i], sacc[1][i]));
        if (MODE == 3 && !lane_ok) mloc = -INFINITY;
      }
      mloc = xh_max(mloc) * a.sc;
      const float mnew = fmaxf(m[qi], mloc);
      const float muse = (mnew == -INFINITY) ? 0.f : mnew;
      const float alpha = fexp2(m[qi] - muse);
      m[qi] = mnew;
      const float muse_l = (MODE == 3 && !lane_ok) ? INFINITY : muse;
      float psum = 0.f;
#pragma unroll
      for (int ksub = 0; ksub < 2; ++ksub)
#pragma unroll
        for (int i = 0; i < 16; ++i) { float pv = fexp2(fmaf(sacc[ksub][i], a.sc, -muse_l)); sacc[ksub][i] = pv; psum += pv; }
      l[qi] = l[qi] * alpha + psum;
      if (__ballot(alpha != 1.f) != 0ull) {
#pragma unroll
        for (int i = 0; i < 16; ++i) { o[qi][0][i] *= alpha; o[qi][1][i] *= alpha; }
      }
#pragma unroll
      for (int s4 = 0; s4 < 4; ++s4) {
        const bf16x8 pf = pack8(sacc[s4 >> 1], 8 * (s4 & 1));
        const bf16x8 v0 = *(const bf16x8*)(st + voff + (((s4 * 2 + h) ^ vswz) << 4));
        const bf16x8 v1 = *(const bf16x8*)(st + voff + 4096 + (((s4 * 2 + h) ^ vswz) << 4));
        o[qi][0] = MFMA32(v0, pf, o[qi][0]);
        o[qi][1] = MFMA32(v1, pf, o[qi][1]);
      }
      __builtin_amdgcn_sched_barrier(0);
    }
    if (kt1 < nt) at_stage<NKS2>(smem + (buf ^ 1) * AT_STAGE, g, tid);
    if (kt2 < nt) g = at_issue<NKS2>(a, kt2, tid);
    __syncthreads();
    kt = kt1; kt1 = kt2; buf ^= 1;
  }
  attn_store(p, o[0], 1.f / xh_sum(l[0]), rowbase + q0w + r, br, head, lane);
  attn_store(p, o[1], 1.f / xh_sum(l[1]), rowbase + q0w + 32 + r, br, head, lane);
}

DI void attn_blk_diff(const Params& p, int layer, int b, int head, int q0, int tid, char* smem) {
  const int lane = tid & 63, wave = tid >> 6, r = lane & 31, h = lane >> 5;
  const bf16* P = (const bf16*)(p.ws + OFF_P);
  AttnArgs a;
  a.Q = P + (size_t)b * SEQ * PW + P_CQ + head * 64; a.qs = PW;
  a.K1 = P + (size_t)b * SEQ * PW + P_CK + head * 64; a.k1s = PW;
  a.K2 = nullptr; a.k2s = 0;
  a.Vt = (const bf16*)(p.ws + OFF_VTC) + (size_t)(b * 4 + head) * 64 * SEQ; a.vts = SEQ;
  a.q0 = q0; a.sc = 0.17677669529663687f * LOG2E; a.mask = nullptr; a.kbar = nullptr;
  const int qfirst = q0 + wave * 32;
  bf16x8 qf[4];
#pragma unroll
  for (int ks = 0; ks < 4; ++ks) qf[ks] = ldg8(a.Q + (size_t)(qfirst + r) * PW + ks * 16 + 8 * h);
  f32x16 o1[2], o2[2];
  o1[0] = zero16(); o1[1] = zero16(); o2[0] = zero16(); o2[1] = zero16();
  float m1 = -INFINITY, l1 = 0.f, m2 = -INFINITY, l2 = 0.f;
  const float sc = a.sc;
  const int pr = pi_perm(r);
  const int koff = pr * 128, kswz = (pr >> 1) & 7;
  const int voff = 8192 + r * 128, vswz = (r >> 1) & 7;
  const int nt = ((q0 + 127) >> 6) + 1;
  AtRegs g = at_issue<0>(a, 0, tid);
  at_stage<0>(smem, g, tid);
  if (1 < nt) g = at_issue<0>(a, 1, tid);
  __syncthreads();
  int buf = 0;
  for (int kt = 0; kt < nt; ++kt) {
    const char* st = smem + buf * AT_STAGE;
    if (64 * kt <= qfirst + 31) {
      f32x16 s1[2], s2[2];
#pragma unroll
      for (int ksub = 0; ksub < 2; ++ksub) {
        bf16x8 kf[4];
#pragma unroll
        for (int ks = 0; ks < 4; ++ks) kf[ks] = *(const bf16x8*)(st + ksub * 4096 + koff + (((ks * 2 + h) ^ kswz) << 4));
        f32x16 x1 = zero16(), x2 = zero16();
        x1 = MFMA32(kf[0], qf[0], x1); x2 = MFMA32(kf[2], qf[2], x2);
        x1 = MFMA32(kf[1], qf[1], x1); x2 = MFMA32(kf[3], qf[3], x2);
        s1[ksub] = x1; s2[ksub] = x2;
      }
      const bool diag = (64 * kt + 63 > qfirst);
      float ml1 = -INFINITY, ml2 = -INFINITY;
      if (diag) {
#pragma unroll
        for (int ksub = 0; ksub < 2; ++ksub)
#pragma unroll
          for (int i = 0; i < 16; ++i) {
            bool ok = (64 * kt + 32 * ksub + keyidx(i, h) <= qfirst + r);
            float x = ok ? s1[ksub][i] : -INFINITY, y = ok ? s2[ksub][i] : -INFINITY;
            s1[ksub][i] = x; s2[ksub][i] = y;
            ml1 = fmaxf(ml1, x); ml2 = fmaxf(ml2, y);
          }
      } else {
#pragma unroll
        for (int i = 0; i < 16; ++i) {
          ml1 = fmaxf(ml1, fmaxf(s1[0][i], s1[1][i]));
          ml2 = fmaxf(ml2, fmaxf(s2[0][i], s2[1][i]));
        }
      }
      ml1 = xh_max(ml1) * sc; ml2 = xh_max(ml2) * sc;
      const float mn1 = fmaxf(m1, ml1), mn2 = fmaxf(m2, ml2);
      const float al1 = fexp2(m1 - mn1), al2 = fexp2(m2 - mn2);
      m1 = mn1; m2 = mn2;
      float ps1 = 0.f, ps2 = 0.f;
#pragma unroll
      for (int ksub = 0; ksub < 2; ++ksub)
#pragma unroll
        for (int i = 0; i < 16; ++i) {
          float x = fexp2(fmaf(s1[ksub][i], sc, -mn1)), y = fexp2(fmaf(s2[ksub][i], sc, -mn2));
          s1[ksub][i] = x; s2[ksub][i] = y; ps1 += x; ps2 += y;
        }
      l1 = l1 * al1 + ps1; l2 = l2 * al2 + ps2;
      if (__ballot((al1 != 1.f) || (al2 != 1.f)) != 0ull) {
#pragma unroll
        for (int i = 0; i < 16; ++i) { o1[0][i] *= al1; o1[1][i] *= al1; o2[0][i] *= al2; o2[1][i] *= al2; }
      }
#pragma unroll
      for (int s4 = 0; s4 < 4; ++s4) {
        const bf16x8 p1 = pack8(s1[s4 >> 1], 8 * (s4 & 1)), p2 = pack8(s2[s4 >> 1], 8 * (s4 & 1));
        const bf16x8 v0 = *(const bf16x8*)(st + voff + (((s4 * 2 + h) ^ vswz) << 4));
        const bf16x8 v1 = *(const bf16x8*)(st + voff + 4096 + (((s4 * 2 + h) ^ vswz) << 4));
        o1[0] = MFMA32(v0, p1, o1[0]); o1[1] = MFMA32(v1, p1, o1[1]);
        o2[0] = MFMA32(v0, p2, o2[0]); o2[1] = MFMA32(v1, p2, o2[1]);
      }
    }
    if (kt + 1 < nt) at_stage<0>(smem + (buf ^ 1) * AT_STAGE, g, tid);
    if (kt + 2 < nt) g = at_issue<0>(a, kt + 2, tid);
    __syncthreads();
    buf ^= 1;
  }
  l1 = xh_sum(l1); l2 = xh_sum(l2);
  const float* dl = p.diff_lam + (size_t)layer * 128;
  float d01 = dl[r] * dl[32 + r], d23 = dl[64 + r] * dl[96 + r];
#pragma unroll
  for (int off = 16; off >= 1; off >>= 1) { d01 += __shfl_xor(d01, off); d23 += __shfl_xor(d23, off); }
  const float lam_init = 0.8f - 0.6f * expf(-0.3f * (float)layer);
  const float lam = expf(d01) - expf(d23) + lam_init;
  const float i1 = 1.f / l1, i2 = lam / l2;
  float ss = 0.f;
#pragma unroll
  for (int dt = 0; dt < 2; ++dt)
#pragma unroll
    for (int i = 0; i < 16; ++i) { float v = o1[dt][i] * i1 - o2[dt][i] * i2; o1[dt][i] = v; ss += v * v; }
  ss = xh_sum(ss);
  const float rs = rsqrtf(ss * (1.f / 64.f) + 1e-6f) * (1.f - lam_init);
  const float* dn = p.diff_norm + (size_t)layer * 64;
#pragma unroll
  for (int dt = 0; dt < 2; ++dt)
#pragma unroll
    for (int i = 0; i < 16; ++i) o1[dt][i] *= dn[dt * 32 + crow(i, h)];
  attn_store(p, o1, rs, b * SEQ + qfirst + r, 2, head, lane);
}

DI void dsa_scores(const Params& p, int b, int qt, int kt0, int kt1, int lane) {
  const int r = lane & 31, h = lane >> 5;
  const bf16* P = (const bf16*)(p.ws + OFF_P) + (size_t)b * SEQ * PW;
  const float* IW = (const float*)(p.ws + OFF_IW) + (size_t)b * SEQ * 8;
  float* SC = (float*)(p.ws + OFF_SC) + (size_t)b * SC_PB + (size_t)1024 * ((size_t)qt * (qt + 1) / 2);
  const int q = qt * 32 + r;
  bf16x8 qf[8][2];
#pragma unroll
  for (int ih = 0; ih < 8; ++ih)
#pragma unroll
    for (int ks = 0; ks < 2; ++ks) qf[ih][ks] = ldg8(P + (size_t)q * PW + P_IQ + ih * 32 + ks * 16 + 8 * h);
  float w[8];
#pragma unroll
  for (int ih = 0; ih < 8; ++ih) w[ih] = IW[(size_t)q * 8 + ih] * 0.0625f;
  const int rowlen = (qt + 1) * 32;
  float* rowp = SC + (size_t)r * rowlen;
  for (int kt = kt0; kt < kt1; ++kt) {
    bf16x8 k0 = ldg8(P + (size_t)(kt * 32 + r) * PW + P_IK + 8 * h);
    bf16x8 k1 = ldg8(P + (size_t)(kt * 32 + r) * PW + P_IK + 16 + 8 * h);
    f32x16 sc = zero16();
#pragma unroll
    for (int ih = 0; ih < 8; ++ih) {
      f32x16 s = zero16();
      s = MFMA32(k0, qf[ih][0], s);
      s = MFMA32(k1, qf[ih][1], s);
#pragma unroll
      for (int i = 0; i < 16; ++i) sc[i] += fmaxf(s[i], 0.f) * w[ih];
      if (ih & 1) __builtin_amdgcn_sched_barrier(0);
    }
#pragma unroll
    for (int g = 0; g < 4; ++g) {
      float4 v = make_float4(sc[4 * g], sc[4 * g + 1], sc[4 * g + 2], sc[4 * g + 3]);
      *(float4*)(rowp + kt * 32 + 8 * g + 4 * h) = v;
    }
  }
}

DI const float* dsa_rowptr(const Params& p, int n, int& t, int& ngr) {
  const int b = n >> 12;
  t = n & (SEQ - 1);
  const int qt = t >> 5, r = t & 31;
  const int rowlen = (qt + 1) * 32;
  ngr = (((rowlen + 63) >> 6) + 7) >> 3;
  return (const float*)(p.ws + OFF_SC) + (size_t)b * SC_PB + (size_t)1024 * ((size_t)qt * (qt + 1) / 2) + (size_t)r * rowlen;
}
DI void dsa_select_wave(const Params& p, int nfirst, int nstride, int lane) {
  uint32_t u[64], f[64];
  int n = nfirst;
  if (n < 0) return;
  int t, ngr;
  {
    const float* rowp = dsa_rowptr(p, n, t, ngr);
#pragma unroll
    for (int g = 0; g < 8; ++g) {
      if (g < ngr) {
#pragma unroll
        for (int e = 0; e < 8; ++e) { int j = (g * 8 + e) * 64 + lane; f[g * 8 + e] = __float_as_uint(rowp[j <= t ? j : t]); }
      }
    }
  }
  while (n >= 0) {
#pragma unroll
    for (int g = 0; g < 8; ++g) {
#pragma unroll
      for (int e = 0; e < 8; ++e) {
        const int c = g * 8 + e, j = c * 64 + lane;
        uint32_t bits = f[c];
        uint32_t key = (bits & 0x80000000u) ? ~bits : (bits | 0x80000000u);
        u[c] = (g < ngr && j <= t) ? key : 0u;
      }
    }
    const int tc = t, ngc = ngr, nc = n;
    n -= nstride;
    if (n >= 0) {
      const float* rowp = dsa_rowptr(p, n, t, ngr);
#pragma unroll
      for (int g = 0; g < 8; ++g) {
        if (g < ngr) {
#pragma unroll
          for (int e = 0; e < 8; ++e) { int j = (g * 8 + e) * 64 + lane; f[g * 8 + e] = __float_as_uint(rowp[j <= t ? j : t]); }
        }
      }
    }
    uint32_t* mk = (uint32_t*)(p.ws + OFF_MASK) + (size_t)nc * 128;
    const int nch = (((tc >> 5) + 1) * 32 + 63) >> 6;
    uint32_t tau = 0u;
    int need_eq = 0;
    const bool all = (tc + 1 <= 256);
    bool exact = false;
    if (!all) {
      for (int bit = 31; bit >= 0; --bit) {
        const uint32_t cand = tau | (1u << bit);
        int cv = 0;
#pragma unroll
        for (int g = 0; g < 8; ++g) {
          if (g < ngc) {
#pragma unroll
            for (int e = 0; e < 8; ++e) cv += (int)(u[g * 8 + e] >= cand);
          }
        }
        int cnt = 0;
#pragma unroll
        for (int k = 0; k < 7; ++k) cnt += __popcll(__ballot((cv >> k) & 1)) << k;
        if (cnt >= 256) { tau = cand; if (cnt == 256) { exact = true; break; } }
      }
      if (!exact) {
        int cgt = 0;
#pragma unroll
        for (int g = 0; g < 8; ++g) {
          if (g < ngc) {
#pragma unroll
            for (int e = 0; e < 8; ++e) cgt += __popcll(__ballot(u[g * 8 + e] > tau));
          }
        }
        need_eq = 256 - cgt;
      }
    }
    int eq_seen = 0;
    const uint64_t lt_mask = (lane == 0) ? 0ull : (~0ull >> (64 - lane));
#pragma unroll
    for (int g = 0; g < 8; ++g) {
      if (g < ngc) {
#pragma unroll
        for (int e = 0; e < 8; ++e) {
          const int c = g * 8 + e;
          uint64_t selb;
          if (all) {
            selb = __ballot(u[c] != 0u);
          } else if (exact) {
            selb = __ballot(u[c] >= tau);
          } else {
            uint64_t gtb = __ballot(u[c] > tau);
            uint64_t eqb = __ballot(u[c] == tau);
            int myrank = eq_seen + __popcll(eqb & lt_mask);
            uint64_t eqsel = __ballot((u[c] == tau) && (myrank < need_eq));
            eq_seen += __popcll(eqb);
            selb = gtb | eqsel;
          }
          if (lane == 0 && c < nch) {
            mk[2 * c] = (uint32_t)selb;
            mk[2 * c + 1] = (uint32_t)(selb >> 32);
          }
        }
      }
    }
  }
}

#define XB_TMO      128
#define XB_XCNT(j)  (256  + 64 * (j))
#define XB_XSUB(j)  (1280 + 64 * (j))
#define XB_XGEN(j)  (2304 + 64 * (j))
#define XB_TOP      3328
#define XB_TOPGEN   3392
#define XCD_BAR_WORDS 3456
#define XB_SPIN_CAP (1u << 18)
#define LAS __attribute__((address_space(3)))

__device__ __forceinline__ unsigned xb_ld(unsigned* p)              { return __hip_atomic_load(p, __ATOMIC_RELAXED, __HIP_MEMORY_SCOPE_AGENT); }
__device__ __forceinline__ unsigned xb_add(unsigned* p, unsigned v) { return __hip_atomic_fetch_add(p, v, __ATOMIC_RELAXED, __HIP_MEMORY_SCOPE_AGENT); }
__device__ __forceinline__ unsigned xb_xcc_id() { return (unsigned)__builtin_amdgcn_s_getreg((3 << 11) | 20) & 0xFu; }
#define XB_SPIN(cond, bar) do { unsigned _sp = 0; while (cond) { __builtin_amdgcn_s_sleep(1); \
    if ((++_sp & 255u) == 0u) { if (xb_ld(&(bar)[XB_TMO])) break; if (_sp > XB_SPIN_CAP) { atomicAdd(&(bar)[XB_TMO], 1u); break; } } } } while (0)

struct XcdBarrier {
    unsigned* bar; unsigned x;
    volatile LAS unsigned* st;
};

__device__ __forceinline__ XcdBarrier xcd_barrier_post(unsigned* bar, volatile LAS unsigned* st) {
    XcdBarrier b; b.bar = bar; b.x = xb_xcc_id(); b.st = st;
    if (threadIdx.x == 0) (void)xb_add(&bar[XB_XCNT(b.x)], 1u);
    return b;
}
__device__ __forceinline__ void xcd_barrier_complete(unsigned* bar, unsigned x, unsigned& nloc, unsigned& nx) {
    const unsigned G = gridDim.x * gridDim.y * gridDim.z;
    unsigned sum, cnt, mine, sp = 0u;
    for (;;) {
        sum = 0u; cnt = 0u; mine = 0u;
#pragma unroll
        for (unsigned j = 0; j < 16; ++j) { const unsigned c = xb_ld(&bar[XB_XCNT(j)]); sum += c; cnt += (c > 0u) ? 1u : 0u; mine = (j == x) ? c : mine; }
        if (sum == G) break;
        __builtin_amdgcn_s_sleep(1);
        if ((++sp & 255u) == 0u) { if (xb_ld(&bar[XB_TMO])) break; if (sp > XB_SPIN_CAP) { atomicAdd(&bar[XB_TMO], 1u); break; } }
    }
    nloc = mine > 0u ? mine : 1u; nx = cnt > 0u ? cnt : 1u;
}

__device__ __forceinline__ void xcd_barrier(const XcdBarrier& b) {
    asm volatile("s_waitcnt vmcnt(0)" ::: "memory");
    __syncthreads();
    if (threadIdx.x == 0) {
        unsigned* bar = b.bar;
        __builtin_amdgcn_s_waitcnt(0);
        unsigned nloc = b.st[0], nx = b.st[1];
        if (nloc == 0u) { xcd_barrier_complete(bar, b.x, nloc, nx); b.st[0] = nloc; b.st[1] = nx; }
        const unsigned old = xb_add(&bar[XB_XSUB(b.x)], 1u);
        const unsigned gen = old / nloc;
        if (old + 1u == (gen + 1u) * nloc) {
            __builtin_amdgcn_fence(__ATOMIC_RELEASE, "agent");
            asm volatile("s_waitcnt vmcnt(0)" ::: "memory");
            const unsigned og = xb_add(&bar[XB_TOP], 1u);
            const unsigned tg = og / nx;
            if (og + 1u == (tg + 1u) * nx) xb_add(&bar[XB_TOPGEN], 1u);
            else XB_SPIN(xb_ld(&bar[XB_TOPGEN]) == tg, bar);
            __builtin_amdgcn_fence(__ATOMIC_ACQUIRE, "agent");
            xb_add(&bar[XB_XGEN(b.x)], 1u);
            asm volatile("s_waitcnt vmcnt(0)" ::: "memory");
        } else {
            XB_SPIN(xb_ld(&bar[XB_XGEN(b.x)]) == gen, bar);
            __builtin_amdgcn_fence(__ATOMIC_ACQUIRE, "agent");
            asm volatile("s_waitcnt vmcnt(0)" ::: "memory");
        }
    }
    __syncthreads();
}


#define LAUNDER()                                                                                      \
  int tid;                                                                                             \
  asm volatile("v_mbcnt_lo_u32_b32 %0, -1, 0\n\tv_mbcnt_hi_u32_b32 %0, -1, %0" : "=v"(tid));              \
  tid |= wave_s << 6;                                                                                  \
  asm volatile("" : "+v"(tid));                                                                        \
  Params p = p0;                                                                                       \
  size_t zoff = 0;                         \
  asm volatile("" : "+s"(zoff));           \
  p.ws = p0.ws + zoff;                                                                                 \
  p.out = p0.out + zoff;                                                                               \
  const int lane = tid & 63, wave = tid >> 6;                                                          \
  char* ws = p.ws;                                                                                     \
  bf16* HB = (bf16*)(ws + OFF_HB);                                                                     \
  bf16* WINT = (bf16*)(ws + OFF_WINT);                                                                 \
  bf16* P = (bf16*)(ws + OFF_P);                                                                       \
  float* rope = (float*)(ws + OFF_ROPE);                                                               \
  (void)lane; (void)wave; (void)HB; (void)WINT; (void)P; (void)rope;

__global__ void __launch_bounds__(256, 2) mega(Params p0) {
  __shared__ __attribute__((aligned(16))) char smem[65536];
  __shared__ float s_rs[128];
  __shared__ uint4 xb_words;
  __shared__ int s_item;
  __shared__ unsigned s_blk;
  cg::grid_group grid = cg::this_grid();
  const int wave_s = __builtin_amdgcn_readfirstlane((int)(threadIdx.x >> 6));
  if (threadIdx.x == 0) xb_words = make_uint4(0u, 0u, 0u, 0u);
  __syncthreads();
  (void)xcd_barrier_post((unsigned*)(p0.ws + OFF_BAR), (volatile LAS unsigned*)&xb_words);
#define XBAR() do { XcdBarrier xb_; xb_.bar = (unsigned*)(p0.ws + OFF_BAR); xb_.x = xb_xcc_id(); xb_.st = (volatile LAS unsigned*)&xb_words; xcd_barrier(xb_); xcd_barrier(xb_); } while (0)

  grid.sync();

  {
  LAUNDER();
  const int gtid = blockIdx.x * 256 + tid, gthreads = gridDim.x * 256;
  ln_rows(p.x, p.ln0_g, p.ln0_b, p.out, HB, tid);
  for (int i = gtid; i < SEQ * 28; i += gthreads) {
    int t = i / 28, f = i % 28;
    int rot, fi, co, so;
    if (f < 8) { rot = 16; fi = f; co = R_CS64 + t * 8 + fi; so = R_SN64 + t * 8 + fi; }
    else if (f < 12) { rot = 8; fi = f - 8; co = R_CS32 + t * 4 + fi; so = R_SN32 + t * 4 + fi; }
    else { rot = 32; fi = f - 12; co = R_CSM + t * 16 + fi; so = R_SNM + t * 16 + fi; }
    float inv = (float)pow(500000.0, -(double)(2 * fi) / (double)rot);
    float ang = (float)t * inv;
    rope[co] = (float)cos((double)ang);
    rope[so] = (float)sin((double)ang);
  }
  {
    bf16* MEMB = (bf16*)(ws + OFF_MEMB);
    for (int i = gtid; i < NB * NMEM * DM / 2; i += gthreads) {
      float2 v = ((const float2*)p.mem)[i];
      ((uint32_t*)MEMB)[i] = pack2(v.x, v.y);
    }
  }
  for (int t = blockIdx.x; t < 2432 + DEPTH * 744; t += gridDim.x) {
    if (t < 2432) {
      conv_tile<true>(p.w_in, 1024, INW, WINT, nullptr, smem, tid, t);
    } else {
      const int u = t - 2432, l = u / 744;
      int v = u % 744;
      if (v < 320) {
        const int n = v >> 6;
        conv_tile<false>(p.w_branch + ((size_t)l * 5 + n) * 256 * 1024, 256, 1024,
                         (bf16*)(ws + OFF_WBT) + ((size_t)l * 5 + n) * 1024 * 256, nullptr, smem, tid, v & 63);
      } else if ((v -= 320) < 256) {
        conv_tile<false>(p.w_out + (size_t)l * 1024 * 1024, 1024, 1024, (bf16*)(ws + OFF_WOT) + (size_t)l * 1024 * 1024, nullptr, smem, tid, v);
      } else if ((v -= 256) < 24) {
        conv_tile<false>(p.w_uq + (size_t)l * 256 * 384, 256, 384, (bf16*)(ws + OFF_WUQT) + (size_t)l * 384 * 256, p.mla_q_norm + l * 256, smem, tid, v);
      } else if ((v -= 24) < 16) {
        conv_tile<false>(p.w_ukv + (size_t)l * 128 * 512, 128, 512, (bf16*)(ws + OFF_WUKVT) + (size_t)l * 512 * 128, p.mla_kv_norm + l * 128, smem, tid, v);
      } else {
        v -= 16;
        conv_tile<false>(p.w_mem_kv + (size_t)l * 1024 * 512, 1024, 512, (bf16*)(ws + OFF_WMKVT) + (size_t)l * 512 * 1024, nullptr, smem, tid, v);
      }
    }
  }
  }
  XBAR();

  for (int layer = 0; layer < DEPTH; ++layer) {
    {
      LAUNDER();
      const int nt_in = 128 * 76;
      const int nt_tot = nt_in + (layer == 0 ? DEPTH * 32 : 0);
      auto tile_ptrs = [&](int it, const bf16*& Ap, const bf16*& Bp) {
        if (it < nt_in) {
          Ap = HB + (size_t)(it & 127) * 128 * 1024;
          Bp = WINT + (size_t)(it >> 7) * 128 * 1024;
        } else {
          const int j = it - nt_in, l = j >> 5, mt = (j & 31) >> 2, nt = j & 3;
          Ap = (const bf16*)(ws + OFF_MEMB) + (size_t)mt * 128 * 1024;
          Bp = (const bf16*)(ws + OFF_WMKVT) + ((size_t)l * 512 + nt * 128) * 1024;
        }
      };
      GStage g;
      {
        const bf16 *Ap, *Bp;
        tile_ptrs(blockIdx.x, Ap, Bp);
        g = gemm_issue(Ap, 1024, Bp, 1024, 0, tid);
      }
      for (int it = blockIdx.x; it < nt_tot; it += gridDim.x) {
        f32x16 acc[2][2];
        acc[0][0] = zero16(); acc[0][1] = zero16(); acc[1][0] = zero16(); acc[1][1] = zero16();
        const bf16 *Ap, *Bp;
        tile_ptrs(it, Ap, Bp);
        int t2 = tid;
        gemm_core_u<16>(Ap, 1024, Bp, 1024, acc, smem, t2, g);
        if (it + (int)gridDim.x < nt_tot) {
          const bf16 *An, *Bn;
          tile_ptrs(it + gridDim.x, An, Bn);
          g = gemm_issue(An, 1024, Bn, 1024, 0, t2);
        }
        if (it < nt_in) {
          int mt = it & 127, ct = it >> 7;
          epi_inproj(p, acc, mt, ct, t2, smem);
        } else {
          int j = it - nt_in, l = j >> 5, mt = (j & 31) >> 2, nt = j & 3;
          const int wm = t2 >> 7, wn = (t2 >> 6) & 1, r = t2 & 31, h = (t2 >> 5) & 1;
#pragma unroll
          for (int mi = 0; mi < 2; ++mi)
#pragma unroll
            for (int ni = 0; ni < 2; ++ni) {
              asm volatile("" ::: "memory");
              int rowb = mt * 128 + wm * 64 + mi * 32;
              int col = nt * 128 + wn * 64 + ni * 32 + r;
              if (nt < 2) {
                store_rm((bf16*)(ws + OFF_MK) + (size_t)l * 1024 * 256, 256, rowb, col, acc[mi][ni], h);
              } else {
                int bb = rowb >> 8, c2 = col - 256;
                bf16* vt = (bf16*)(ws + OFF_VTM) + ((size_t)(l * 4 + bb) * 4 + (c2 >> 6)) * 64 * 256;
                store_vt(vt, 256, c2 & 63, rowb & 255, acc[mi][ni], h);
              }
            }
        }
      }
    }
    XBAR();

    {
      LAUNDER();
      for (int wi = blockIdx.x * 4 + wave; wi < 4 * 1088; wi += gridDim.x * 4) {
        const int b = wi & 3;
        int idx = 1087 - (wi >> 2);
        int jg = 0;
        while (4 * (jg + 1) * (jg + 2) <= idx) ++jg;
        const int rem = idx - 4 * jg * (jg + 1);
        const int qt = 8 * jg + rem / (jg + 1), c = rem % (jg + 1);
        const int kt1 = (8 * c + 8 < qt + 1) ? 8 * c + 8 : qt + 1;
        dsa_scores(p, b, qt, 8 * c, kt1, lane);
      }
    }
    {
      LAUNDER();
      for (int it = blockIdx.x; it < 128 * 3; it += gridDim.x) {
          constexpr bool isq = true;
          int j = it;
          int mt = isq ? j / 3 : j >> 2, nt = isq ? j % 3 : j & 3;
          constexpr int KK = isq ? 256 : 128;
          const bf16* A = P + (size_t)mt * 128 * PW + (isq ? P_DCQ : P_DCKV);
          {
            int row = tid >> 1, half = tid & 1;
            const bf16* ap = A + (size_t)row * PW + half * (KK / 2);
            float ss = 0.f;
            for (int c = 0; c < KK / 16; ++c) {
              bf16x8 v = ldg8(ap + c * 8);
#pragma unroll
              for (int e = 0; e < 8; ++e) { float f = bf2f((bf16)v[e]); ss += f * f; }
            }
            ss += __shfl_xor(ss, 1);
            if (half == 0) s_rs[row] = rsqrtf(ss / (float)KK + 1e-6f);
          }
          f32x16 acc[2][2];
          acc[0][0] = zero16(); acc[0][1] = zero16(); acc[1][0] = zero16(); acc[1][1] = zero16();
          const bf16* Bt = isq ? (const bf16*)(ws + OFF_WUQT) + ((size_t)layer * 384 + nt * 128) * 256
                               : (const bf16*)(ws + OFF_WUKVT) + ((size_t)layer * 512 + nt * 128) * 128;
          int t2 = tid;
          gemm_full<KK / 64>(A, PW, Bt, KK, acc, smem, t2);
          const int wm = t2 >> 7, wn = (t2 >> 6) & 1, r = t2 & 31, h = (t2 >> 5) & 1;
#pragma unroll
          for (int mi = 0; mi < 2; ++mi)
#pragma unroll
            for (int ni = 0; ni < 2; ++ni) {
              asm volatile("" ::: "memory");
              f32x16 v = acc[mi][ni];
              int rl = wm * 64 + mi * 32;
              int rowb = mt * 128 + rl;
#pragma unroll
              for (int i = 0; i < 16; ++i) v[i] *= s_rs[rl + crow(i, h)];
              if (isq) {
                int ctile = nt * 4 + wn * 2 + ni;
                if (ctile % 3 == 2) rope_tile<16>(v, r, h, rowb, rope + R_CSM, rope + R_SNM);
                store_rm((bf16*)(ws + OFF_QF), 384, rowb, ctile * 32 + r, v, h);
              } else {
                if (wn == 0) {
                  store_rm((bf16*)(ws + OFF_KN), 256, rowb, nt * 64 + ni * 32 + r, v, h);
                } else {
                  int bb = rowb >> 12;
                  bf16* vt = (bf16*)(ws + OFF_VTD) + (size_t)(bb * 4 + nt) * 64 * SEQ;
                  store_vt(vt, SEQ, ni * 32 + r, rowb & (SEQ - 1), v, h);
                }
              }
            }
          __syncthreads();
      }
    }
    {
      LAUNDER();
      for (int it = blockIdx.x; it < 128 * 4; it += gridDim.x) {
          constexpr bool isq = false;
          int j = it;
          int mt = isq ? j / 3 : j >> 2, nt = isq ? j % 3 : j & 3;
          constexpr int KK = isq ? 256 : 128;
          const bf16* A = P + (size_t)mt * 128 * PW + (isq ? P_DCQ : P_DCKV);
          {
            int row = tid >> 1, half = tid & 1;
            const bf16* ap = A + (size_t)row * PW + half * (KK / 2);
            float ss = 0.f;
            for (int c = 0; c < KK / 16; ++c) {
              bf16x8 v = ldg8(ap + c * 8);
#pragma unroll
              for (int e = 0; e < 8; ++e) { float f = bf2f((bf16)v[e]); ss += f * f; }
            }
            ss += __shfl_xor(ss, 1);
            if (half == 0) s_rs[row] = rsqrtf(ss / (float)KK + 1e-6f);
          }
          f32x16 acc[2][2];
          acc[0][0] = zero16(); acc[0][1] = zero16(); acc[1][0] = zero16(); acc[1][1] = zero16();
          const bf16* Bt = isq ? (const bf16*)(ws + OFF_WUQT) + ((size_t)layer * 384 + nt * 128) * 256
                               : (const bf16*)(ws + OFF_WUKVT) + ((size_t)layer * 512 + nt * 128) * 128;
          int t2 = tid;
          gemm_full<KK / 64>(A, PW, Bt, KK, acc, smem, t2);
          const int wm = t2 >> 7, wn = (t2 >> 6) & 1, r = t2 & 31, h = (t2 >> 5) & 1;
#pragma unroll
          for (int mi = 0; mi < 2; ++mi)
#pragma unroll
            for (int ni = 0; ni < 2; ++ni) {
              asm volatile("" ::: "memory");
              f32x16 v = acc[mi][ni];
              int rl = wm * 64 + mi * 32;
              int rowb = mt * 128 + rl;
#pragma unroll
              for (int i = 0; i < 16; ++i) v[i] *= s_rs[rl + crow(i, h)];
              if (isq) {
                int ctile = nt * 4 + wn * 2 + ni;
                if (ctile % 3 == 2) rope_tile<16>(v, r, h, rowb, rope + R_CSM, rope + R_SNM);
                store_rm((bf16*)(ws + OFF_QF), 384, rowb, ctile * 32 + r, v, h);
              } else {
                if (wn == 0) {
                  store_rm((bf16*)(ws + OFF_KN), 256, rowb, nt * 64 + ni * 32 + r, v, h);
                } else {
                  int bb = rowb >> 12;
                  bf16* vt = (bf16*)(ws + OFF_VTD) + (size_t)(bb * 4 + nt) * 64 * SEQ;
                  store_vt(vt, SEQ, ni * 32 + r, rowb & (SEQ - 1), v, h);
                }
              }
            }
          __syncthreads();
      }
    }
    {
      LAUNDER();
      for (int it = (int)gridDim.x - 1 - (int)blockIdx.x; it < 64; it += gridDim.x) {
        const int bb = it >> 4, blk = it & 15;
        const int cg = tid & 31, rsub = tid >> 5;
        const bf16* kp = P + ((size_t)bb * SEQ + blk * 256 + rsub) * PW + P_BK + cg * 8;
        float a8[8];
#pragma unroll
        for (int e = 0; e < 8; ++e) a8[e] = 0.f;
#pragma unroll 8
        for (int k = 0; k < 32; ++k) {
          const uint4 v = *(const uint4*)(kp + (size_t)k * 8 * PW);
          const uint32_t w[4] = {v.x, v.y, v.z, v.w};
#pragma unroll
          for (int e = 0; e < 4; ++e) { a8[2 * e] += bf2f((bf16)(w[e] & 0xffffu)); a8[2 * e + 1] += bf2f((bf16)(w[e] >> 16)); }
        }
        float* red = (float*)smem;
#pragma unroll
        for (int e = 0; e < 8; ++e) red[rsub * 256 + cg * 8 + e] = a8[e];
        __syncthreads();
        float sacc = 0.f;
#pragma unroll
        for (int q = 0; q < 8; ++q) sacc += red[q * 256 + tid];
        ((bf16*)(ws + OFF_KBAR))[((size_t)(bb * 4 + (tid >> 6)) * 32 + blk) * 64 + (tid & 63)] = f2bf(sacc * (1.f / 256.f));
        __syncthreads();
      }
    }
    XBAR();

    {
      LAUNDER();
      dsa_select_wave(p, NTOK - 1 - (int)(blockIdx.x * 4 + wave), (int)gridDim.x * 4, lane);
    }
    XBAR();

    {
    LAUNDER();
    unsigned* qctr = (unsigned*)(ws + OFF_BAR) + XCD_BAR_WORDS + layer * 16;
    for (int dx = 0; dx < 8; ++dx) {
      const int xq = ((int)xb_xcc_id() + dx) & 7;
      for (;;) {
        if (tid == 0) s_item = (int)atomicAdd(&qctr[xq], 1u);
        __syncthreads();
        const int kq = s_item;
        __syncthreads();
        if (kq >= 192) break;
        int tid_i = tid;
        asm volatile("" : "+v"(tid_i));
      int br, qt, sub;
      if (kq < 64) { br = 2; qt = 31 - (kq >> 1); sub = kq & 1; }
      else {
        const int k2 = kq - 64, gp = k2 >> 5, rem = k2 & 31;
        br = gp == 0 ? 3 : (gp == 1 ? 0 : (gp == 2 ? 1 : 4));
        qt = 15 - (rem >> 1); sub = rem & 1;
      }
      const int bh = xq + 8 * sub;
      const int b = bh >> 2, head = bh & 3;
      if (br == 2) {
        attn_blk_diff(p, layer, b, head, qt * 128, tid_i, smem);
      } else {
        const int q0 = qt * 256;
        AttnArgs a;
        a.q0 = q0; a.mask = nullptr; a.kbar = nullptr; a.K2 = nullptr; a.k2s = 0;
        const bf16* Pb = P + (size_t)b * SEQ * PW;
        if (br == 0) {
          a.Q = Pb + P_AQ + head * 64; a.qs = PW; a.K1 = Pb + P_AK + head * 64; a.k1s = PW;
          a.Vt = (const bf16*)(ws + OFF_VTA) + (size_t)(b * 4 + head) * 64 * SEQ; a.vts = SEQ;
          a.sc = 0.125f * LOG2E; a.mask = (const uint32_t*)(ws + OFF_MASK) + (size_t)b * SEQ * 128;
          attn_blk_std<2, 0>(p, a, 0, tid_i, br, head, b * SEQ, smem, &s_blk);
        } else if (br == 1) {
          a.Q = Pb + P_BQ + head * 64; a.qs = PW; a.K1 = Pb + P_BK + head * 64; a.k1s = PW;
          a.Vt = (const bf16*)(ws + OFF_VTB) + (size_t)(b * 4 + head) * 64 * SEQ; a.vts = SEQ;
          a.sc = 0.125f * LOG2E; a.kbar = (const bf16*)(ws + OFF_KBAR) + (size_t)(b * 4 + head) * 32 * 64;
          attn_blk_std<3, 0>(p, a, 0, tid_i, br, head, b * SEQ, smem, &s_blk);
        } else if (br == 3) {
          a.Q = (const bf16*)(ws + OFF_QF) + (size_t)b * SEQ * 384 + head * 96; a.qs = 384;
          a.K1 = (const bf16*)(ws + OFF_KN) + (size_t)b * SEQ * 256 + head * 64; a.k1s = 256;
          a.K2 = Pb + P_KR; a.k2s = PW;
          a.Vt = (const bf16*)(ws + OFF_VTD) + (size_t)(b * 4 + head) * 64 * SEQ; a.vts = SEQ;
          a.sc = 0.10206207261596575f * LOG2E;
          attn_blk_std<0, 2>(p, a, 0, tid_i, br, head, b * SEQ, smem, &s_blk);
        } else {
          a.Q = Pb + P_EQ + head * 64; a.qs = PW;
          a.K1 = (const bf16*)(ws + OFF_MK) + ((size_t)layer * 1024 + b * 256) * 256 + head * 64; a.k1s = 256;
          a.Vt = (const bf16*)(ws + OFF_VTM) + ((size_t)(layer * 4 + b) * 4 + head) * 64 * 256; a.vts = 256;
          a.sc = 0.125f * LOG2E;
          attn_blk_std<1, 0>(p, a, 4, tid_i, br, head, b * SEQ, smem, &s_blk);
        }
      }
      }
    }
    }
    XBAR();

    {
    LAUNDER();
    for (int it = blockIdx.x; it < 1024; it += gridDim.x) {
      const int mt = it & 127, nt = it >> 7;
      float sum[8][8];
#pragma unroll
      for (int ps = 0; ps < 8; ++ps)
#pragma unroll
        for (int e = 0; e < 8; ++e) sum[ps][e] = 0.f;
      for (int n = 0; n < 5; ++n) {
        int t2 = tid;
        uint4 gq[8];
        {
          const bf16* gp = P + (size_t)(mt * 128 + (t2 >> 4)) * PW + P_G + n * 1024 + nt * 128 + (t2 & 15) * 8;
#pragma unroll
          for (int ps = 0; ps < 4; ++ps) gq[ps] = *(const uint4*)(gp + (size_t)ps * 16 * PW);
        }
        f32x16 acc[2][2];
        acc[0][0] = zero16(); acc[0][1] = zero16(); acc[1][0] = zero16(); acc[1][1] = zero16();
        gemm_full_loop((const bf16*)(ws + OFF_Y) + (size_t)mt * 128 * 1280 + n * 256, 1280,
                  (const bf16*)(ws + OFF_WBT) + (((size_t)layer * 5 + n) * 1024 + nt * 128) * 256, 256, 256, acc, smem, t2);
        {
          const bf16* gp = P + (size_t)(mt * 128 + (t2 >> 4)) * PW + P_G + n * 1024 + nt * 128 + (t2 & 15) * 8;
#pragma unroll
          for (int ps = 4; ps < 8; ++ps) gq[ps] = *(const uint4*)(gp + (size_t)ps * 16 * PW);
        }
        float* C = (float*)smem;
        {
          const int wm = t2 >> 7, wn = (t2 >> 6) & 1, r = t2 & 31, h = (t2 >> 5) & 1;
#pragma unroll
          for (int mi = 0; mi < 2; ++mi)
#pragma unroll
            for (int ni = 0; ni < 2; ++ni)
#pragma unroll
              for (int i = 0; i < 16; ++i)
                C[(wm * 64 + mi * 32 + crow(i, h)) * 128 + wn * 64 + ni * 32 + r] = acc[mi][ni][i];
        }
        __syncthreads();
#pragma unroll
        for (int ps = 0; ps < 8; ++ps) {
          float x[8];
          ld8(C + (ps * 16 + (t2 >> 4)) * 128 + (t2 & 15) * 8, x);
          const uint32_t gw[4] = {gq[ps].x, gq[ps].y, gq[ps].z, gq[ps].w};
#pragma unroll
          for (int e = 0; e < 4; ++e) {
            sum[ps][2 * e] += bf2f((bf16)(gw[e] & 0xffffu)) * x[2 * e];
            sum[ps][2 * e + 1] += bf2f((bf16)(gw[e] >> 16)) * x[2 * e + 1];
          }
        }
        __syncthreads();
      }
#pragma unroll
      for (int ps = 0; ps < 8; ++ps)
        st8((bf16*)(ws + OFF_MERGED) + (size_t)(mt * 128 + ps * 16 + (tid >> 4)) * 1024 + nt * 128 + (tid & 15) * 8, sum[ps]);
    }
    }
    XBAR();

    {
    LAUNDER();
    for (int it = blockIdx.x; it < 1024; it += gridDim.x) {
      const int mt = it & 127, nt = it >> 7;
      f32x16 acc[2][2];
      acc[0][0] = zero16(); acc[0][1] = zero16(); acc[1][0] = zero16(); acc[1][1] = zero16();
      int t2 = tid;
      float* op = p.out + (size_t)(mt * 128 + (t2 >> 4)) * DM + nt * 128 + (t2 & 15) * 8;
      gemm_full<16>((const bf16*)(ws + OFF_MERGED) + (size_t)mt * 128 * 1024, 1024,
                (const bf16*)(ws + OFF_WOT) + ((size_t)layer * 1024 + nt * 128) * 1024, 1024, acc, smem, t2);
      float* C = (float*)smem;
      {
        const int wm = t2 >> 7, wn = (t2 >> 6) & 1, r = t2 & 31, h = (t2 >> 5) & 1;
#pragma unroll
        for (int mi = 0; mi < 2; ++mi)
#pragma unroll
          for (int ni = 0; ni < 2; ++ni)
#pragma unroll
            for (int i = 0; i < 16; ++i)
              C[(wm * 64 + mi * 32 + crow(i, h)) * 128 + wn * 64 + ni * 32 + r] = acc[mi][ni][i];
      }
      op = p.out + (size_t)(mt * 128 + (t2 >> 4)) * DM + nt * 128 + (t2 & 15) * 8;
      float4 ra[8], rb[8];
#pragma unroll
      for (int ps = 0; ps < 8; ++ps) { ra[ps] = *(const float4*)(op + (size_t)ps * 16 * DM); rb[ps] = *(const float4*)(op + (size_t)ps * 16 * DM + 4); }
      __syncthreads();
#pragma unroll
      for (int ps = 0; ps < 8; ++ps) {
        float x[8];
        ld8(C + (ps * 16 + (t2 >> 4)) * 128 + (t2 & 15) * 8, x);
        float4 o0, o1;
        o0.x = DN_ALPHA * ra[ps].x + x[0]; o0.y = DN_ALPHA * ra[ps].y + x[1]; o0.z = DN_ALPHA * ra[ps].z + x[2]; o0.w = DN_ALPHA * ra[ps].w + x[3];
        o1.x = DN_ALPHA * rb[ps].x + x[4]; o1.y = DN_ALPHA * rb[ps].y + x[5]; o1.z = DN_ALPHA * rb[ps].z + x[6]; o1.w = DN_ALPHA * rb[ps].w + x[7];
        *(float4*)(op + (size_t)ps * 16 * DM) = o0;
        *(float4*)(op + (size_t)ps * 16 * DM + 4) = o1;
      }
      __syncthreads();
    }
    }
    XBAR();

    {
    LAUNDER();
    ln_rows(p.out, p.ln_g + layer * DM, p.ln_b + layer * DM, p.out, HB, tid);
    if (layer + 1 < DEPTH) {
      conv_matrix<true>(p.w_in + (size_t)(layer + 1) * 1024 * INW, 1024, INW, WINT, nullptr, smem, tid);
    }
    }
    if (layer + 1 < DEPTH) XBAR();
  }
}

extern "C" void kernel_launch(void* const* d_in, const int* in_sizes, int n_in, void* d_out, int out_size, void* d_ws,
                              size_t ws_size, hipStream_t stream) {
  static int grid_blocks = 0;
  if (!grid_blocks) {
    int dev = 0, cus = 0, per_cu = 0;
    hipGetDevice(&dev);
    hipDeviceGetAttribute(&cus, hipDeviceAttributeMultiprocessorCount, dev);
    hipOccupancyMaxActiveBlocksPerMultiprocessor(&per_cu, mega, 256, 0);
    if (per_cu > 2) per_cu = 2;
    grid_blocks = cus * per_cu;
  }
  if (ws_size < WS_TOTAL) { fprintf(stderr, "workspace too small: %zu < %zu\n", ws_size, (size_t)WS_TOTAL); return; }
  Params p{};
  p.x = (const float*)d_in[0]; p.mem = (const float*)d_in[1]; p.ln0_g = (const float*)d_in[2]; p.ln0_b = (const float*)d_in[3];
  p.w_in = (const float*)d_in[4]; p.mla_q_norm = (const float*)d_in[5]; p.w_uq = (const float*)d_in[6];
  p.mla_kv_norm = (const float*)d_in[7]; p.w_ukv = (const float*)d_in[8]; p.diff_lam = (const float*)d_in[9];
  p.diff_norm = (const float*)d_in[10]; p.w_mem_kv = (const float*)d_in[11]; p.w_branch = (const float*)d_in[12];
  p.w_out = (const float*)d_in[13]; p.ln_g = (const float*)d_in[14]; p.ln_b = (const float*)d_in[15];
  p.out = (float*)d_out; p.ws = (char*)d_ws;
  hipMemsetAsync((char*)d_ws + OFF_BAR, 0, 16384, stream);
  void* args[] = {&p};
  hipError_t e = hipLaunchCooperativeKernel((void*)mega, dim3(grid_blocks), dim3(256), args, 0, stream);
  if (e != hipSuccess) fprintf(stderr, "cooperative launch failed: %s (grid %d)\n", hipGetErrorString(e), grid_blocks);
}
```
